# Optimizing an MI355X kernel written in HIP

```python
import jax, jax.numpy as jnp
from jax import lax
import numpy as np

D_MODEL = 1024
BATCH = 4
SEQ = 4096
DEPTH = 1

EPS = 1e-6
N_SUB = 3
D_FF = 2816
CHUNK = 64
HG_HEADS = 4
HG_DK = 128
HG_DV = 128
HG_QK = HG_HEADS * HG_DK
HG_WIDTH = HG_HEADS * HG_DV
GLA_HEADS = 4
GLA_DK = 64
GLA_DV = 128
GLA_K = GLA_HEADS * GLA_DK
GLA_V = GLA_HEADS * GLA_DV
GLA_RANK = 16
GLA_NORMALIZER = 16.0
IN_SPLITS = (HG_QK, HG_QK, HG_WIDTH, HG_WIDTH,
             GLA_K, GLA_K, GLA_V, GLA_V, GLA_RANK,
             D_MODEL, D_MODEL)
IN_WIDTH = sum(IN_SPLITS)
IN_OFFSETS = tuple(int(o) for o in np.cumsum(IN_SPLITS)[:-1])

kernel_name = 'hybrid_hgrn2_gla_macaron_adaln'


def rms_norm(x, gain):
    xf = x.astype(jnp.float32)
    y = xf * lax.rsqrt(jnp.mean(xf * xf, axis=-1, keepdims=True) + EPS)
    return (y * gain.astype(jnp.float32)).astype(x.dtype)


def modulate(h, shift, scale):
    return h * (1 + scale[:, None, :]) + shift[:, None, :]


def swiglu(h, w_in, w_down):
    gate, up = jnp.split(h @ w_in, 2, axis=-1)
    return (jax.nn.silu(gate) * up) @ w_down


def to_heads(t, n_heads):
    b, s, w = t.shape
    return t.reshape(b, s, n_heads, w // n_heads).transpose(0, 2, 1, 3)


def from_heads(t):
    b, h, s, d = t.shape
    return t.transpose(0, 2, 1, 3).reshape(b, s, h * d)


def chunked_gated_linear_attention(q, k, v, log_a):
    b_, h_, t_, dk = q.shape
    dv = v.shape[-1]
    n = t_ // CHUNK

    def to_chunks(t):
        return jnp.moveaxis(t.astype(jnp.float32).reshape(b_, h_, n, CHUNK, t.shape[-1]), 2, 0)

    qc, kc, vc, gc = to_chunks(q), to_chunks(k), to_chunks(v), to_chunks(log_a)
    causal = jnp.tril(jnp.ones((CHUNK, CHUNK), dtype=bool))[:, :, None]

    def step(state, inp):
        qi, ki, vi, gi = inp
        b = jnp.cumsum(gi, axis=-2)
        o_inter = jnp.einsum('bhtk,bhkv->bhtv', qi * jnp.exp(b), state)
        diff = b[:, :, :, None, :] - b[:, :, None, :, :]
        decay = jnp.exp(jnp.where(causal, diff, -jnp.inf))
        scores = jnp.einsum('bhtk,bhsk,bhtsk->bhts', qi, ki, decay)
        o = o_inter + jnp.einsum('bhts,bhsv->bhtv', scores, vi)
        b_last = b[:, :, -1:, :]
        k_dec = ki * jnp.exp(b_last - b)
        state = (jnp.exp(b_last[:, :, 0, :])[..., None] * state
                 + jnp.einsum('bhsk,bhsv->bhkv', k_dec, vi))
        return state, o

    s0 = jnp.zeros((b_, h_, dk, dv), jnp.float32)
    _, o = lax.scan(step, s0, (qc, kc, vc, gc))
    return jnp.moveaxis(o, 0, 2).reshape(b_, h_, t_, dv)


def hgrn2_branch(q, f, i, g, lower_bound, norm_gain):
    dtype = i.dtype
    qf = jax.nn.silu(q.astype(jnp.float32))
    forget = lower_bound + (1 - lower_bound) * jax.nn.sigmoid(f.astype(jnp.float32))
    o = chunked_gated_linear_attention(to_heads(qf, HG_HEADS), to_heads(1 - forget, HG_HEADS),
                                       to_heads(i, HG_HEADS), to_heads(jnp.log(forget), HG_HEADS))
    o = rms_norm(o, norm_gain) * jax.nn.silu(to_heads(g, HG_HEADS).astype(jnp.float32))
    return from_heads(o).astype(dtype)


def gla_branch(q, k, v, g, gk_low, w_gk_up, b_gk_up, norm_gain):
    dtype = v.dtype
    gk = gk_low @ w_gk_up + b_gk_up
    log_a = jax.nn.log_sigmoid(gk.astype(jnp.float32)) / GLA_NORMALIZER
    qs = q.astype(jnp.float32) * (GLA_DK ** -0.5)
    o = chunked_gated_linear_attention(to_heads(qs, GLA_HEADS), to_heads(k, GLA_HEADS),
                                       to_heads(v, GLA_HEADS), to_heads(log_a, GLA_HEADS))
    o = rms_norm(o, norm_gain) * jax.nn.silu(to_heads(g, GLA_HEADS).astype(jnp.float32))
    return from_heads(o).astype(dtype)


def setup_inputs(seed: int = 0) -> dict:
    key = jax.random.key(seed)
    ks = jax.random.split(key, 20)
    D = D_MODEL

    def w(k, shape, fan_in, s=1.0):
        return jax.random.normal(k, shape, jnp.float32) * (s * fan_in ** -0.5)

    return {
        'x': jax.random.normal(ks[0], (BATCH, SEQ, D), jnp.float32),
        'c': jax.random.normal(ks[1], (BATCH, D), jnp.float32),
        'w_ada': w(ks[2], (DEPTH, D, N_SUB * 3 * D), D, 0.5),
        'b_ada': 0.02 * jax.random.normal(ks[3], (DEPTH, N_SUB * 3 * D), jnp.float32),
        'norm_gains': 1.0 + 0.02 * jax.random.normal(ks[4], (DEPTH, N_SUB, D), jnp.float32),
        'ffn1_w_in': w(ks[5], (DEPTH, D, 2 * D_FF), D),
        'ffn1_w_down': w(ks[6], (DEPTH, D_FF, D), D_FF),
        'w_in_mix': w(ks[7], (DEPTH, D, IN_WIDTH), D),
        'w_gk_up': w(ks[8], (DEPTH, GLA_RANK, GLA_K), GLA_RANK),
        'b_gk_up': 0.1 * jax.random.normal(ks[9], (DEPTH, GLA_K), jnp.float32),
        'lb_logits': 0.5 * jax.random.normal(ks[10], (DEPTH + 1, HG_QK), jnp.float32),
        'hg_norm': 1.0 + 0.02 * jax.random.normal(ks[11], (DEPTH, HG_DV), jnp.float32),
        'gla_norm': 1.0 + 0.02 * jax.random.normal(ks[12], (DEPTH, GLA_DV), jnp.float32),
        'w_up_hg': w(ks[13], (DEPTH, HG_WIDTH, D), HG_WIDTH),
        'w_up_gla': w(ks[14], (DEPTH, GLA_V, D), GLA_V),
        'w_out': w(ks[15], (DEPTH, D, D), D),
        'ffn2_w_in': w(ks[16], (DEPTH, D, 2 * D_FF), D),
        'ffn2_w_down': w(ks[17], (DEPTH, D_FF, D), D_FF),
        'final_norm': 1.0 + 0.02 * jax.random.normal(ks[18], (D,), jnp.float32),
    }


def reference(x, c, w_ada, b_ada, norm_gains, ffn1_w_in, ffn1_w_down, w_in_mix,
              w_gk_up, b_gk_up, lb_logits, hg_norm, gla_norm, w_up_hg, w_up_gla,
              w_out, ffn2_w_in, ffn2_w_down, final_norm):
    b_, _, d = x.shape
    lower_bounds = jnp.cumsum(jax.nn.softmax(lb_logits.astype(jnp.float32), axis=0), axis=0)
    cond = jax.nn.silu(c)
    for l in range(DEPTH):
        mod = (cond @ w_ada[l] + b_ada[l]).reshape(b_, N_SUB, 3, d)

        h = modulate(rms_norm(x, norm_gains[l, 0]), mod[:, 0, 0], mod[:, 0, 1])
        x = x + 0.5 * mod[:, 0, 2][:, None, :] * swiglu(h, ffn1_w_in[l], ffn1_w_down[l])

        h = modulate(rms_norm(x, norm_gains[l, 1]), mod[:, 1, 0], mod[:, 1, 1])
        proj = h @ w_in_mix[l]
        (hq, hf, hi, hg, gq, gk, gv, gg, g_low, r_hg, r_gla) = jnp.split(proj, IN_OFFSETS, axis=-1)
        y_hg = hgrn2_branch(hq, hf, hi, hg, lower_bounds[l], hg_norm[l])
        y_gla = gla_branch(gq, gk, gv, gg, g_low, w_gk_up[l], b_gk_up[l], gla_norm[l])
        merged = (jax.nn.sigmoid(r_hg) * (y_hg @ w_up_hg[l])
                  + jax.nn.sigmoid(r_gla) * (y_gla @ w_up_gla[l]))
        x = x + mod[:, 1, 2][:, None, :] * (merged @ w_out[l])

        h = modulate(rms_norm(x, norm_gains[l, 2]), mod[:, 2, 0], mod[:, 2, 1])
        x = x + 0.5 * mod[:, 2, 2][:, None, :] * swiglu(h, ffn2_w_in[l], ffn2_w_down[l])
    return rms_norm(x, final_norm)
```

```cpp
#include <hip/hip_runtime.h>
#include <hip/hip_cooperative_groups.h>
#include <cstdio>
namespace cg = cooperative_groups;
namespace pg8 {
#define PG8_LAS __attribute__((address_space(3)))
typedef unsigned short bf16_t;
typedef short bf16x8 __attribute__((ext_vector_type(8)));
typedef float f32x4 __attribute__((ext_vector_type(4)));
typedef unsigned u32x4 __attribute__((ext_vector_type(4)));
constexpr int BM = 256, BK = 64, HALF = 128, HTB = HALF * BK * 2  , STAGE_BYTES = 8 * HTB, NXCD = 8, WGM = 8;

__host__ __device__ __forceinline__ int lds_byte(int r, int c) { const int st = (r >> 4) * 2 + (c >> 5), rr = r & 15, cc = c & 31, ob = rr * 64 + cc * 2; return st * 1024 + (ob ^ (((ob >> 9) & 1) << 5)); }
__host__ __device__ __forceinline__ void stage_rc(int b, int& R, int& C) { const int st = b / 1024, sb = b % 1024, swz = sb ^ (((sb >> 9) & 1) << 5); R = (st >> 1) * 16 + swz / 64; C = (st & 1) * 32 + (swz % 64) / 2; }
__host__ __device__ __forceinline__ int perm32(int rho) { const int n = rho >> 4, i = rho & 15; return 8 * (i >> 2) + 4 * n + (i & 3); }

struct Unit { int pm, pn; };
struct Gemm { const bf16_t* A; const bf16_t* Bt; int M, N, K; };

struct StaticOrder {
    int nM, nN, nwg, G, c;
    __host__ __device__ void init(int M, int N, int G_, int c_) { nM = M / BM; nN = N / BM; nwg = nM * nN; G = G_; c = c_; }
    __host__ __device__ bool next(int i, Unit& u) const {
        const long L = (long)i * G + c; if (L >= nwg) return false;
        int wgid = (int)L; { const int q = nwg / NXCD, r = nwg % NXCD, xcd = wgid % NXCD, off = wgid / NXCD; wgid = (xcd < r ? xcd * (q + 1) : r * (q + 1) + (xcd - r) * q) + off; }
        const int nig = WGM * nN, gid = wgid / nig, fm = gid * WGM, gsz = (nM - fm) < WGM ? (nM - fm) : WGM;
        u.pm = fm + ((wgid % nig) % gsz); u.pn = (wgid % nig) / gsz; return true;
    }
    __device__ __forceinline__ void a_ready(const Unit&) const {}
    __device__ __forceinline__ void done(const Unit&) const {}
};
struct CountedOrder : StaticOrder {
    const unsigned* ready; unsigned need; unsigned* tmo;
    __device__ __forceinline__ void a_ready(const Unit& u) const {
        if (threadIdx.x < 64) {
            const unsigned long long t0 = __builtin_amdgcn_s_memrealtime(); unsigned polls = 0;
            while ((unsigned)__builtin_amdgcn_readfirstlane(__hip_atomic_load(ready + 64 * u.pm, __ATOMIC_RELAXED, __HIP_MEMORY_SCOPE_AGENT)) < need) {
                if ((++polls & 255u) == 0u && __builtin_amdgcn_readfirstlane(__hip_atomic_load(tmo, __ATOMIC_RELAXED, __HIP_MEMORY_SCOPE_AGENT)) != 0u) break;
                if (__builtin_amdgcn_s_memrealtime() - t0 > 2000000ull) {
                    if (threadIdx.x == 0) { unsigned expect = 0u; __hip_atomic_compare_exchange_strong(tmo + 1, &expect, 0x600u | (unsigned)(u.pm & 0xff), __ATOMIC_RELAXED, __ATOMIC_RELAXED, __HIP_MEMORY_SCOPE_AGENT); __hip_atomic_store(tmo, 1u, __ATOMIC_RELAXED, __HIP_MEMORY_SCOPE_AGENT); }
                    break; }
                __builtin_amdgcn_s_sleep(2); }
            __builtin_amdgcn_fence(__ATOMIC_ACQUIRE, "agent");
            asm volatile("s_waitcnt vmcnt(0)" ::: "memory");
        }
#if !defined(BROKEN_HOOK_NO_BARRIER)
        asm volatile("" ::: "memory"); __builtin_amdgcn_s_barrier(); asm volatile("" ::: "memory");
#endif
    }
};

__device__ __forceinline__ unsigned cvt_pk_bf16(float lo, float hi) { unsigned r; asm volatile("v_cvt_pk_bf16_f32 %0, %1, %2" : "=v"(r) : "v"(lo), "v"(hi)); return r; }
typedef float f32x2 __attribute__((ext_vector_type(2)));
__device__ __forceinline__ f32x2 gelu_pk(f32x2 v) {
    const f32x2 av = __builtin_elementwise_abs(v), d = av * 0.2316418882f + 1.0f;
    f32x2 t; t.x = __builtin_amdgcn_rcpf(d.x); t.y = __builtin_amdgcn_rcpf(d.y);
    f32x2 q = t * 0.5307027145f + (-0.7265760135f); q = q * t + 0.7107068705f; q = q * t + (-0.142248368f); q = q * t + 0.127414796f; q = q * t;
    const f32x2 s = (v * v) * (-0.72134752044f);
    f32x2 e; e.x = __builtin_amdgcn_exp2f(s.x); e.y = __builtin_amdgcn_exp2f(s.y);
    const f32x2 m = v * (q * e), r = v - m;
    f32x2 o; o.x = v.x < 0.f ? m.x : r.x; o.y = v.y < 0.f ? m.y : r.y; return o;
}

struct EpiF32 {
    static constexpr bool PERM = false, AFTER_DRAIN = false;
    float* C; int ldc; const float* bias;
    __device__ __forceinline__ void operator()(const f32x4 (&acc)[2][2][4][2], const Unit& u, int wr, int wc, int fr, int fq) const {
        const int row0 = u.pm * BM + wr * 64 + fr, col0 = u.pn * BM + wc * 32 + 4 * fq;
        f32x4 bv[2][2];
#pragma unroll
        for (int bj = 0; bj < 2; ++bj)
#pragma unroll
            for (int n = 0; n < 2; ++n) bv[bj][n] = bias ? *(const f32x4*)(bias + col0 + bj * HALF + n * 16) : (f32x4){0.f, 0.f, 0.f, 0.f};
#pragma unroll
        for (int ai = 0; ai < 2; ++ai)
#pragma unroll
            for (int m = 0; m < 4; ++m) { float* rowp = C + (size_t)(row0 + ai * HALF + m * 16) * ldc + col0;
#pragma unroll
                for (int bj = 0; bj < 2; ++bj)
#pragma unroll
                    for (int n = 0; n < 2; ++n) *(f32x4*)(rowp + bj * HALF + n * 16) = acc[ai][bj][m][n] + bv[bj][n]; }
    }
};
template <int ACT  > struct EpiBf16 {
    static constexpr bool PERM = true, AFTER_DRAIN = false;
    bf16_t* O; int ldc; const float* bias; int split_cols; size_t split_stride;
    __device__ __forceinline__ void operator()(const f32x4 (&acc)[2][2][4][2], const Unit& u, int wr, int wc, int fr, int fq) const {
        const int row0 = u.pm * BM + wr * 64 + fr; int colt = u.pn * BM; bf16_t* base = O;
        if (split_cols) { const int t = colt / split_cols; base += (size_t)t * split_stride; colt -= t * split_cols; }
        const int col0 = colt + wc * 32 + 8 * fq, bcol0 = u.pn * BM + wc * 32 + 8 * fq;
        f32x4 bv[2][2];
#pragma unroll
        for (int bj = 0; bj < 2; ++bj)
#pragma unroll
            for (int n = 0; n < 2; ++n) bv[bj][n] = bias ? *(const f32x4*)(bias + bcol0 + bj * HALF + 4 * n) : (f32x4){0.f, 0.f, 0.f, 0.f};
#pragma unroll
        for (int ai = 0; ai < 2; ++ai)
#pragma unroll
            for (int m = 0; m < 4; ++m) { bf16_t* rowp = base + (size_t)(row0 + ai * HALF + m * 16) * ldc + col0;
#pragma unroll
                for (int bj = 0; bj < 2; ++bj) { f32x4 v0 = acc[ai][bj][m][0] + bv[bj][0], v1 = acc[ai][bj][m][1] + bv[bj][1];
                    if (ACT == 1) { f32x2 a = gelu_pk((f32x2){v0[0], v0[1]}), b = gelu_pk((f32x2){v0[2], v0[3]}), c = gelu_pk((f32x2){v1[0], v1[1]}), d = gelu_pk((f32x2){v1[2], v1[3]});
                        v0 = (f32x4){a.x, a.y, b.x, b.y}; v1 = (f32x4){c.x, c.y, d.x, d.y}; }
                    if (ACT == 2) {
#pragma unroll
                        for (int j = 0; j < 4; ++j) { v0[j] = 0.5f * v0[j] * (1.0f + erff(v0[j] * 0.70710678f)); v1[j] = 0.5f * v1[j] * (1.0f + erff(v1[j] * 0.70710678f)); } }
                    u32x4 w; w.x = cvt_pk_bf16(v0[0], v0[1]); w.y = cvt_pk_bf16(v0[2], v0[3]); w.z = cvt_pk_bf16(v1[0], v1[1]); w.w = cvt_pk_bf16(v1[2], v1[3]);
                    *(u32x4*)(rowp + bj * HALF) = w; } }
    }
};

struct PanelStats {
    unsigned* xbuf;
    unsigned* cnt;
    unsigned* tmo;
    int ntn; float eps;
    unsigned code;
    __device__ __forceinline__ bool run(const f32x4 (&v)[2][2][4][2], const Unit& u, int wr, int wc, int fr, int fq, PG8_LAS unsigned char* lds, int wid, int lane) const {
        typedef float f32x2v __attribute__((ext_vector_type(2)));
        PG8_LAS f32x2v* P = (PG8_LAS f32x2v*)lds;
        PG8_LAS f32x2v* S = (PG8_LAS f32x2v*)(lds + 8192);
        PG8_LAS unsigned* flag = (PG8_LAS unsigned*)(lds + 8192 + 2048);
#pragma unroll
        for (int ai = 0; ai < 2; ++ai)
#pragma unroll
            for (int m = 0; m < 4; ++m) {
                float s = 0.f;
#pragma unroll
                for (int bj = 0; bj < 2; ++bj)
#pragma unroll
                    for (int n = 0; n < 2; ++n) { const f32x4 x = v[ai][bj][m][n]; s += (x[0] + x[1]) + (x[2] + x[3]); }
                s += __shfl_xor(s, 16); s += __shfl_xor(s, 32);
                const float mw = s * (1.0f / 64.0f); float q = 0.f;
#pragma unroll
                for (int bj = 0; bj < 2; ++bj)
#pragma unroll
                    for (int n = 0; n < 2; ++n) { const f32x4 d = v[ai][bj][m][n] - mw; q += (d[0] * d[0] + d[1] * d[1]) + (d[2] * d[2] + d[3] * d[3]); }
                q += __shfl_xor(q, 16); q += __shfl_xor(q, 32);
                if (fq == 0) P[(ai * HALF + wr * 64 + m * 16 + fr) * 4 + wc] = (f32x2v){mw, q};
            }
        asm volatile("s_waitcnt lgkmcnt(0)" ::: "memory"); __builtin_amdgcn_s_barrier(); asm volatile("" ::: "memory");
#if defined(BROKEN_NO_WAIT)
        if (blockIdx.x >= 64) { const long long t0 = clock64(); while (clock64() - t0 < 60000) __builtin_amdgcn_s_sleep(8); }
#endif
        const int row = wid * 32 + (lane & 31);
        if (lane < 32) {
            const f32x2v a = P[row * 4 + 0], b = P[row * 4 + 1], c = P[row * 4 + 2], d = P[row * 4 + 3];
            const float mt = (a.x + b.x + c.x + d.x) * 0.25f;
            const float da = a.x - mt, db = b.x - mt, dc = c.x - mt, dd = d.x - mt;
            const float m2 = (a.y + b.y) + (c.y + d.y) + 64.0f * ((da * da + db * db) + (dc * dc + dd * dd));
            unsigned long long* slot = (unsigned long long*)xbuf + ((size_t)(u.pm * BM + row) * 4 + u.pn);
            __hip_atomic_store(slot, ((unsigned long long)__float_as_uint(m2) << 32) | __float_as_uint(mt), __ATOMIC_RELAXED, __HIP_MEMORY_SCOPE_AGENT);
        }
        asm volatile("s_waitcnt vmcnt(0)" ::: "memory");
        if (lane == 0) __hip_atomic_fetch_add(cnt + 64 * u.pm, 1u, __ATOMIC_RELAXED, __HIP_MEMORY_SCOPE_AGENT);
        if (wid == 0) {
            bool dead = false; const unsigned long long t0 = __builtin_amdgcn_s_memrealtime(); const unsigned want = 8u * (unsigned)ntn;
            for (;;) {
#if defined(BROKEN_NO_WAIT)
                break;
#endif
                if ((unsigned)__builtin_amdgcn_readfirstlane(__hip_atomic_load(cnt + 64 * u.pm, __ATOMIC_RELAXED, __HIP_MEMORY_SCOPE_AGENT)) >= want) break;
                if (__builtin_amdgcn_s_memrealtime() - t0 > 2000000ull) {
                    if (lane == 0) { unsigned expect = 0u; __hip_atomic_compare_exchange_strong(tmo + 1, &expect, code | (unsigned)(u.pm & 0xff), __ATOMIC_RELAXED, __ATOMIC_RELAXED, __HIP_MEMORY_SCOPE_AGENT);
                                     __hip_atomic_store(tmo, 1u, __ATOMIC_RELAXED, __HIP_MEMORY_SCOPE_AGENT); }
                    dead = true; break; }
                __builtin_amdgcn_s_sleep(2);
            }
            __builtin_amdgcn_fence(__ATOMIC_ACQUIRE, "agent");
            if (lane == 0) flag[0] = dead ? 1u : 0u;
        }
        asm volatile("s_waitcnt vmcnt(0) lgkmcnt(0)" ::: "memory"); __builtin_amdgcn_s_barrier(); asm volatile("" ::: "memory");
        const bool bad = flag[0] != 0u;
        if (lane < 32) {
            const unsigned long long* slot = (const unsigned long long*)xbuf + (size_t)(u.pm * BM + row) * 4; float mt[4], m2[4]; float ms = 0.f;
#pragma unroll
            for (int t = 0; t < 4; ++t) { if (t < ntn) { const unsigned long long w = __hip_atomic_load(slot + t, __ATOMIC_RELAXED, __HIP_MEMORY_SCOPE_AGENT); mt[t] = __uint_as_float((unsigned)w); m2[t] = __uint_as_float((unsigned)(w >> 32)); } else { mt[t] = 0.f; m2[t] = 0.f; } ms += mt[t]; }
            const float mean = ms / (float)ntn; float q = 0.f;
#pragma unroll
            for (int t = 0; t < 4; ++t) if (t < ntn) { const float dm = mt[t] - mean; q += m2[t] + 256.0f * dm * dm; }
            S[row] = (f32x2v){mean, 1.0f / sqrtf(q / (256.0f * (float)ntn) + eps)};
        }
        asm volatile("s_waitcnt lgkmcnt(0)" ::: "memory"); __builtin_amdgcn_s_barrier(); asm volatile("" ::: "memory");
        return bad;
    }
};
struct EpiLnRes {
    static constexpr bool PERM = false, AFTER_DRAIN = true;
    const float* base; float* out; int ldc; const float* bias; PanelStats st; unsigned poison;
    __device__ __forceinline__ void refuse(size_t i0, size_t stride, int M, int N) const { const float q = __builtin_nanf(""); for (size_t i = i0; i < (size_t)M * N; i += stride) out[(i / N) * ldc + i % N] = q;
        if (i0 == 0) { unsigned expect = 0u; __hip_atomic_compare_exchange_strong(st.tmo + 1, &expect, 0x7f0u, __ATOMIC_RELAXED, __ATOMIC_RELAXED, __HIP_MEMORY_SCOPE_AGENT); __hip_atomic_store(st.tmo, 1u, __ATOMIC_RELAXED, __HIP_MEMORY_SCOPE_AGENT); } }
    __device__ __forceinline__ void fused(f32x4 (&acc)[2][2][4][2], const Unit& u, int wr, int wc, int fr, int fq, PG8_LAS unsigned char* lds, int wid, int lane) const {
        typedef float f32x2v __attribute__((ext_vector_type(2)));
        const PG8_LAS f32x2v* S = (const PG8_LAS f32x2v*)(lds + 8192);
        const int col0 = u.pn * BM + wc * 32 + 4 * fq;
#pragma unroll
        for (int bj = 0; bj < 2; ++bj)
#pragma unroll
            for (int n = 0; n < 2; ++n) { const f32x4 bv = bias ? *(const f32x4*)(bias + col0 + bj * HALF + n * 16) : (f32x4){0.f, 0.f, 0.f, 0.f};
#pragma unroll
                for (int ai = 0; ai < 2; ++ai)
#pragma unroll
                    for (int m = 0; m < 4; ++m) acc[ai][bj][m][n] += bv; }
        const bool bad = st.run(acc, u, wr, wc, fr, fq, lds, wid, lane) || poison != 0u;
        const float qnan = __builtin_nanf("");
#pragma unroll
        for (int ai = 0; ai < 2; ++ai)
#pragma unroll
            for (int m = 0; m < 4; ++m) { const int r = ai * HALF + wr * 64 + m * 16 + fr; const f32x2v sr = S[r]; const size_t off = (size_t)(u.pm * BM + r) * ldc + col0;
#pragma unroll
                for (int bj = 0; bj < 2; ++bj)
#pragma unroll
                    for (int n = 0; n < 2; ++n) { const f32x4 bs = *(const f32x4*)(base + off + bj * HALF + n * 16); f32x4 o = bs + (acc[ai][bj][m][n] - sr.x) * sr.y;
                        if (bad) o = (f32x4){qnan, qnan, qnan, qnan}; *(f32x4*)(out + off + bj * HALF + n * 16) = o; }
                asm volatile("" ::: "memory"); }
    }
};
struct EpiLnResLn {
    static constexpr bool PERM = false, AFTER_DRAIN = true;
    const float* base; float* out; bf16_t* xn; int ldc; const float* bias; PanelStats st1, st2; unsigned poison;
    __device__ __forceinline__ void refuse(size_t i0, size_t stride, int M, int N) const { const float q = __builtin_nanf(""); for (size_t i = i0; i < (size_t)M * N; i += stride) { const size_t o = (i / N) * ldc + i % N; out[o] = q; xn[o] = (bf16_t)0x7fc0u; }
        if (i0 == 0) { unsigned expect = 0u; __hip_atomic_compare_exchange_strong(st1.tmo + 1, &expect, 0x7f0u, __ATOMIC_RELAXED, __ATOMIC_RELAXED, __HIP_MEMORY_SCOPE_AGENT); __hip_atomic_store(st1.tmo, 1u, __ATOMIC_RELAXED, __HIP_MEMORY_SCOPE_AGENT); } }
    __device__ __forceinline__ void fused(f32x4 (&acc)[2][2][4][2], const Unit& u, int wr, int wc, int fr, int fq, PG8_LAS unsigned char* lds, int wid, int lane) const {
        typedef float f32x2v __attribute__((ext_vector_type(2))); typedef unsigned u32x2v __attribute__((ext_vector_type(2)));
        const PG8_LAS f32x2v* S = (const PG8_LAS f32x2v*)(lds + 8192);
        const int col0 = u.pn * BM + wc * 32 + 4 * fq;
#pragma unroll
        for (int bj = 0; bj < 2; ++bj)
#pragma unroll
            for (int n = 0; n < 2; ++n) { const f32x4 bv = bias ? *(const f32x4*)(bias + col0 + bj * HALF + n * 16) : (f32x4){0.f, 0.f, 0.f, 0.f};
#pragma unroll
                for (int ai = 0; ai < 2; ++ai)
#pragma unroll
                    for (int m = 0; m < 4; ++m) acc[ai][bj][m][n] += bv; }
        bool bad = st1.run(acc, u, wr, wc, fr, fq, lds, wid, lane) || poison != 0u;
        const float qnan = __builtin_nanf("");
#pragma unroll
        for (int ai = 0; ai < 2; ++ai)
#pragma unroll
            for (int m = 0; m < 4; ++m) { const int r = ai * HALF + wr * 64 + m * 16 + fr; const f32x2v sr = S[r]; const size_t off = (size_t)(u.pm * BM + r) * ldc + col0;
#pragma unroll
                for (int bj = 0; bj < 2; ++bj)
#pragma unroll
                    for (int n = 0; n < 2; ++n) { const f32x4 bs = *(const f32x4*)(base + off + bj * HALF + n * 16); acc[ai][bj][m][n] = bs + (acc[ai][bj][m][n] - sr.x) * sr.y; }
                asm volatile("" : "+v"(acc[ai][0][m][0]), "+v"(acc[ai][0][m][1]), "+v"(acc[ai][1][m][0]), "+v"(acc[ai][1][m][1]));
                if (m & 1) asm volatile("" ::: "memory"); }
        const bool bad1 = bad;
        bad = st2.run(acc, u, wr, wc, fr, fq, lds, wid, lane) || bad;
#pragma unroll
        for (int ai = 0; ai < 2; ++ai)
#pragma unroll
            for (int m = 0; m < 4; ++m) { const int r = ai * HALF + wr * 64 + m * 16 + fr; const f32x2v sr = S[r]; const size_t off = (size_t)(u.pm * BM + r) * ldc + col0;
#pragma unroll
                for (int bj = 0; bj < 2; ++bj)
#pragma unroll
                    for (int n = 0; n < 2; ++n) { const f32x4 x1 = acc[ai][bj][m][n]; *(f32x4*)(out + off + bj * HALF + n * 16) = bad1 ? (f32x4){qnan, qnan, qnan, qnan} : x1;
                        const f32x4 o = (x1 - sr.x) * sr.y; u32x2v w; w.x = cvt_pk_bf16(o[0], o[1]); w.y = cvt_pk_bf16(o[2], o[3]);
                        if (bad) { w.x = 0x7fc07fc0u; w.y = 0x7fc07fc0u; } *(u32x2v*)(xn + off + bj * HALF + n * 16) = w; }
                asm volatile("" ::: "memory"); }
    }
};

template <class Epi, class Sched, bool STAMP = false>
__device__ __forceinline__ void gemm_phase(PG8_LAS unsigned char* lds, const Gemm g, const Sched& S, const Epi& E, unsigned long long* stamps) {
    const int tid = threadIdx.x, wid = __builtin_amdgcn_readfirstlane(tid >> 6), lane = tid & 63, wr = wid >> 2, wc = wid & 3, fr = lane & 15, fq = lane >> 4;
    const int K = g.K, nt = K / BK;
    int ts_lo = 0, ts_hi = 0, nts = 0; const unsigned long long rt_entry = STAMP ? (unsigned long long)wall_clock64() : 0ull;
#define PG8_STAMP() do { if (STAMP && wid == 0 && nts < 64) { const unsigned long long _c = (unsigned long long)clock64(); \
        ts_lo = (lane == nts) ? (int)(unsigned)_c : ts_lo; ts_hi = (lane == nts) ? (int)(unsigned)(_c >> 32) : ts_hi; ++nts; } } while (0)
    PG8_STAMP();
    unsigned voffA[2], voffB[2];
#pragma unroll
    for (int i = 0; i < 2; ++i) { int R, C; stage_rc(tid * 16 + i * 8192, R, C); const int Rb = Epi::PERM ? ((R & ~31) + perm32(R & 31)) : R;
        voffA[i] = (unsigned)(R * K + C) * 2u; voffB[i] = (unsigned)(Rb * K + C) * 2u; }
    const size_t kstep = (size_t)(BK * 2);
    const size_t hstep = (size_t)HALF * K * 2;
    const size_t tstep = 2 * hstep;
    const unsigned ldsw = (unsigned)wid * 1024u;
    const int aoff = lds_byte(wr * 64 + fr, fq * 8), boff = lds_byte(wc * 32 + fr, fq * 8);
#define PG8_SA(b, h) (((b) * 2 + (h)) * HTB)
#define PG8_SB(b, h) ((4 + (b) * 2 + (h)) * HTB)
#define PG8_STAGE(bufoff, gbase, voff) do { _Pragma("unroll") for (int _i = 0; _i < 2; ++_i) \
        __builtin_amdgcn_global_load_lds((const unsigned*)((const char*)(gbase) + (voff)[_i]), (PG8_LAS unsigned*)(lds + (bufoff) + ldsw + _i * 8192), 16, 0, 0); } while (0)
#define PG8_LDA(dst, b, h) do { _Pragma("unroll") for (int m = 0; m < 4; ++m) _Pragma("unroll") for (int k = 0; k < 2; ++k) dst[m][k] = *(const PG8_LAS bf16x8*)(lds + PG8_SA(b, h) + aoff + m * 2048 + k * 1024); } while (0)
#define PG8_LDB(dst, b, h) do { _Pragma("unroll") for (int n = 0; n < 2; ++n) _Pragma("unroll") for (int k = 0; k < 2; ++k) dst[n][k] = *(const PG8_LAS bf16x8*)(lds + PG8_SB(b, h) + boff + n * 2048 + k * 1024); } while (0)
#define PG8_MMA(ai, bj, At, Bt) do { __builtin_amdgcn_s_setprio(1); _Pragma("unroll") for (int m = 0; m < 4; ++m) _Pragma("unroll") for (int n = 0; n < 2; ++n) _Pragma("unroll") for (int k = 0; k < 2; ++k) \
        acc[ai][bj][m][n] = __builtin_amdgcn_mfma_f32_16x16x32_bf16(Bt[n][k], At[m][k], acc[ai][bj][m][n], 0, 0, 0); __builtin_amdgcn_s_setprio(0); } while (0)
#define PG8_WAIT_V(n) asm volatile("s_waitcnt vmcnt(" #n ")" ::: "memory")
#define PG8_WAIT_L(n) asm volatile("s_waitcnt lgkmcnt(" #n ")" ::: "memory")
#define PG8_BAR __builtin_amdgcn_s_barrier()
#define PG8_SCHED __builtin_amdgcn_sched_barrier(0)
    Unit cur, nxt; int ui = 0;
    if (!S.next(0, cur)) return;
    f32x4 acc[2][2][4][2];
#pragma unroll
    for (int a = 0; a < 2; ++a)
#pragma unroll
        for (int b = 0; b < 2; ++b)
#pragma unroll
            for (int m = 0; m < 4; ++m)
#pragma unroll
                for (int n = 0; n < 2; ++n) acc[a][b][m][n] = (f32x4){0.f, 0.f, 0.f, 0.f};
    bf16x8 At[4][2], B0[2][2], B1[2][2];
    const char* cA = (const char*)g.A + (size_t)cur.pm * tstep; const char* cB = (const char*)g.Bt + (size_t)cur.pn * tstep;
    S.a_ready(cur);
    PG8_STAGE(PG8_SB(0, 0), cB, voffB); PG8_STAGE(PG8_SA(0, 0), cA, voffA); PG8_STAGE(PG8_SB(0, 1), cB + hstep, voffB); PG8_STAGE(PG8_SA(0, 1), cA + hstep, voffA);
    if (wr == 1) PG8_BAR;
    PG8_WAIT_V(4); PG8_BAR;
    PG8_STAGE(PG8_SB(1, 0), cB + kstep, voffB); PG8_STAGE(PG8_SA(1, 0), cA + kstep, voffA); PG8_STAGE(PG8_SB(1, 1), cB + hstep + kstep, voffB);
    PG8_WAIT_V(6); PG8_BAR;
    PG8_STAMP();
    for (;;) {
        const bool has_next = S.next(ui + 1, nxt);
        const char* nA = has_next ? (const char*)g.A + (size_t)nxt.pm * tstep : cA; const char* nB = has_next ? (const char*)g.Bt + (size_t)nxt.pn * tstep : cB;
        for (int t = 0; t < nt; t += 2) {
            const bool last = (t == nt - 2);
            const char* a1 = cA + (size_t)(t + 1) * kstep;
            const char* a2 = last ? nA : cA + (size_t)(t + 2) * kstep; const char* b2 = last ? nB : cB + (size_t)(t + 2) * kstep;
            const char* a3 = a2 + kstep; const char* b3 = b2 + kstep;
            if (last && has_next) S.a_ready(nxt);
            PG8_LDB(B0, 0, 0); PG8_SCHED; PG8_LDA(At, 0, 0); PG8_STAGE(PG8_SA(1, 1), a1 + hstep, voffA);
            PG8_WAIT_L(8); PG8_BAR; PG8_WAIT_L(0); PG8_MMA(0, 0, At, B0); PG8_BAR; PG8_SCHED;
            PG8_LDB(B1, 0, 1); PG8_STAGE(PG8_SB(0, 0), b2, voffB);
            PG8_BAR; PG8_WAIT_L(0); PG8_MMA(0, 1, At, B1); PG8_BAR;
            PG8_LDA(At, 0, 1); PG8_STAGE(PG8_SA(0, 0), a2, voffA);
            PG8_BAR; PG8_WAIT_L(0); PG8_MMA(1, 0, At, B0); PG8_BAR; PG8_SCHED;
            PG8_STAGE(PG8_SB(0, 1), b2 + hstep, voffB);
            PG8_WAIT_V(6); PG8_BAR; PG8_MMA(1, 1, At, B1); PG8_BAR;
            PG8_LDB(B0, 1, 0); PG8_SCHED; PG8_LDA(At, 1, 0); PG8_STAGE(PG8_SA(0, 1), a2 + hstep, voffA);
            PG8_WAIT_L(8); PG8_BAR; PG8_WAIT_L(0); PG8_MMA(0, 0, At, B0); PG8_BAR; PG8_SCHED;
            PG8_LDB(B1, 1, 1); PG8_STAGE(PG8_SB(1, 0), b3, voffB);
            PG8_BAR; PG8_WAIT_L(0); PG8_MMA(0, 1, At, B1); PG8_BAR;
            PG8_LDA(At, 1, 1); PG8_STAGE(PG8_SA(1, 0), a3, voffA);
            PG8_BAR; PG8_WAIT_L(0); PG8_MMA(1, 0, At, B0); PG8_BAR; PG8_SCHED;
            PG8_STAGE(PG8_SB(1, 1), b3 + hstep, voffB);
            PG8_WAIT_V(6); PG8_BAR; PG8_MMA(1, 1, At, B1); PG8_BAR;
        }
        PG8_STAMP();
        if constexpr (!Epi::AFTER_DRAIN) { E(acc, cur, wr, wc, fr, fq); S.done(cur); }
        PG8_STAMP();
        if (!has_next) break;
#pragma unroll
        for (int a = 0; a < 2; ++a)
#pragma unroll
            for (int b = 0; b < 2; ++b)
#pragma unroll
                for (int m = 0; m < 4; ++m)
#pragma unroll
                    for (int n = 0; n < 2; ++n) acc[a][b][m][n] = (f32x4){0.f, 0.f, 0.f, 0.f};
        cur = nxt; cA = nA; cB = nB; ++ui;
    }
    PG8_WAIT_V(0);
    if (wr == 0) PG8_BAR;
    PG8_BAR;
    if constexpr (Epi::AFTER_DRAIN) { E.fused(acc, cur, wr, wc, fr, fq, lds, wid, lane); S.done(cur); }
    PG8_STAMP();
    if (STAMP && wid == 0) { stamps[lane] = lane < nts ? (((unsigned long long)(unsigned)ts_hi << 32) | (unsigned)ts_lo) : 0ull;
        if (lane == 62) stamps[62] = rt_entry; if (lane == 63) stamps[63] = (unsigned long long)wall_clock64(); }
#undef PG8_STAMP
#undef PG8_SA
#undef PG8_SB
#undef PG8_STAGE
#undef PG8_LDA
#undef PG8_LDB
#undef PG8_MMA
#undef PG8_WAIT_V
#undef PG8_WAIT_L
#undef PG8_BAR
#undef PG8_SCHED
}
}

#define LAS __attribute__((address_space(3)))
typedef unsigned short bf16_t;
typedef short bf16x8 __attribute__((ext_vector_type(8)));
typedef float f32x4 __attribute__((ext_vector_type(4)));
typedef unsigned u32x4 __attribute__((ext_vector_type(4)));
typedef unsigned u32x2 __attribute__((ext_vector_type(2)));

constexpr int M_ = 16384, D_ = 1024, DFF = 2816, SEQ = 4096, NMIX = 5888, NMOD = 9216;
constexpr size_t MiB = (size_t)1 << 20;
constexpr size_t WS_WMIX = 0, WS_WUPHG = 11 * MiB + MiB / 2, WS_WUPGLA = WS_WUPHG + MiB, WS_WOUT = WS_WUPGLA + MiB,
                 WS_MOD = 15 * MiB + MiB / 2, WS_DECHG = WS_MOD + 256 * 1024, WS_DECGLA = WS_DECHG + 512 * 1024,
                 WS_WFIN = 16 * MiB + MiB / 2, WS_WFDOWN = WS_WFIN + 11 * MiB, WS_H = 33 * MiB, WS_ACT = 65 * MiB,
                 WS_UHG = WS_WFIN, WS_UGLA = WS_UHG + 32 * MiB,
                 WS_HQ = 65 * MiB, WS_HF = 81 * MiB, WS_HI = 97 * MiB, WS_GQ = 113 * MiB, WS_GK = 121 * MiB, WS_GKL = 129 * MiB,
                 WS_GV = 137 * MiB, WS_HG = 153 * MiB, WS_GG = 169 * MiB, WS_RHG = 185 * MiB, WS_RGLA = 217 * MiB, WS_END = 249 * MiB,
                 WS_T = 65 * MiB;
constexpr int LDS_BYTES = 131072;
constexpr int L_QD = 0, L_QM = 18432, L_KM = 36864, L_VT = 55296, L_P = 73728, L_SEG = 82944, L_SS = 87040;

struct Params { const float* in[19]; float* out; unsigned char* ws; };

typedef float f32x2_t __attribute__((ext_vector_type(2)));
typedef __bf16 bf16x2_t __attribute__((ext_vector_type(2)));
__device__ __forceinline__ unsigned cvt_pk(float lo, float hi) { const f32x2_t v = {lo, hi}; return __builtin_bit_cast(unsigned, __builtin_convertvector(v, bf16x2_t)); }
__device__ __forceinline__ float bf_lo(unsigned w) { return __uint_as_float(w << 16); }
__device__ __forceinline__ float bf_hi(unsigned w) { return __uint_as_float(w & 0xffff0000u); }
__device__ __forceinline__ float bf2f(bf16_t h) { return __uint_as_float(((unsigned)h) << 16); }
__device__ __forceinline__ float sigmoidf_(float x) { return __builtin_amdgcn_rcpf(1.0f + __expf(-x)); }
__device__ __forceinline__ float siluf_(float x) { return x * sigmoidf_(x); }

template <class F> __device__ __forceinline__ void cvt_tiles(const float* __restrict__ src, int ld, bf16_t* __restrict__ dst, int N, int K, F srccol) {
    const int tid = threadIdx.x, ntk = K >> 6, nt = (N >> 6) * ntk;
    for (int t = blockIdx.x; t < nt; t += gridDim.x) {
        const int tn = t / ntk, tk = t - tn * ntk, n = tn * 64 + (tid & 63), k = tk * 64 + 8 * (tid >> 6);
        const float* p = src + (size_t)k * ld + srccol(n);
        float v[8];
#pragma unroll
        for (int i = 0; i < 8; ++i) v[i] = p[(size_t)i * ld];
        u32x4 w; w.x = cvt_pk(v[0], v[1]); w.y = cvt_pk(v[2], v[3]); w.z = cvt_pk(v[4], v[5]); w.w = cvt_pk(v[6], v[7]);
        *(u32x4*)(dst + (size_t)n * K + k) = w;
    }
}
__device__ __forceinline__ void cvt_ffn(const float* w_in, const float* w_down, unsigned char* ws) {
    cvt_tiles(w_in, 2 * DFF, (bf16_t*)(ws + WS_WFIN), 2 * DFF, D_, [](int n) { const int j = (n >> 8) * 128 + (n & 127); return (n & 128) ? DFF + j : j; });
    cvt_tiles(w_down, D_, (bf16_t*)(ws + WS_WFDOWN), D_, DFF, [](int n) { return n; });
}
__device__ __forceinline__ void p0_phase(const Params& p, LAS unsigned char* lds) {
    const int tid = threadIdx.x;
    cvt_ffn(p.in[5], p.in[6], p.ws);
    cvt_tiles(p.in[7], 5648, (bf16_t*)(p.ws + WS_WMIX), 5632, D_, [](int n) { return n < 3584 ? n : n + 16; });
    cvt_tiles(p.in[13], D_, (bf16_t*)(p.ws + WS_WUPHG), D_, 512, [](int n) { return n; });
    cvt_tiles(p.in[14], D_, (bf16_t*)(p.ws + WS_WUPGLA), D_, 512, [](int n) { return n; });
    cvt_tiles(p.in[15], D_, (bf16_t*)(p.ws + WS_WOUT), D_, D_, [](int n) { return n; });
    {
        const float* wmix = p.in[7]; const float* wgk = p.in[8]; bf16_t* dst = (bf16_t*)(p.ws + WS_WMIX);
        for (int idx = blockIdx.x * 512 + tid; idx < 256 * 128; idx += gridDim.x * 512) {
            const int j = idx & 255, k0 = (idx >> 8) * 8;
            float wj[16];
#pragma unroll
            for (int r = 0; r < 16; ++r) wj[r] = wgk[r * 256 + j];
            float v[8];
#pragma unroll
            for (int i = 0; i < 8; ++i) { const float* wr = wmix + (size_t)(k0 + i) * 5648 + 3584; float s = 0.f;
#pragma unroll
                for (int r = 0; r < 16; ++r) s += wr[r] * wj[r];
                v[i] = s; }
            u32x4 w; w.x = cvt_pk(v[0], v[1]); w.y = cvt_pk(v[2], v[3]); w.z = cvt_pk(v[4], v[5]); w.w = cvt_pk(v[6], v[7]);
            *(u32x4*)(dst + (size_t)(5632 + j) * D_ + k0) = w;
        }
    }
    {
        const float* c = p.in[1]; const float* wada = p.in[2]; const float* bada = p.in[3];
        float* mod = (float*)(p.ws + WS_MOD);
        LAS float* red = (LAS float*)lds;
        LAS float* sc = (LAS float*)(lds + 8192);
        const int cl = tid & 31, ds = tid >> 5;
        if ((int)blockIdx.x < 288) {
            for (int i = tid; i < 4096; i += 512) sc[i] = siluf_(c[i]);
            __syncthreads();
        }
        for (int it = blockIdx.x; it < 288; it += gridDim.x) {
            const int col = it * 32 + cl;
            float a0 = 0.f, a1 = 0.f, a2 = 0.f, a3 = 0.f;
#pragma unroll 16
            for (int i = 0; i < 64; ++i) { const int d = ds * 64 + i; const float w = wada[(size_t)d * NMOD + col];
                a0 += sc[d] * w; a1 += sc[1024 + d] * w; a2 += sc[2048 + d] * w; a3 += sc[3072 + d] * w; }
            *(LAS f32x4*)(red + (ds * 32 + cl) * 4) = (f32x4){a0, a1, a2, a3};
            __syncthreads();
            if (tid < 128) { const int cl2 = tid & 31, b = tid >> 5; float s = bada[it * 32 + cl2];
#pragma unroll
                for (int q = 0; q < 16; ++q) s += red[(q * 32 + cl2) * 4 + b];
                mod[b * NMOD + it * 32 + cl2] = s; }
            __syncthreads();
        }
    }
}

template <bool MOD> __device__ __forceinline__ void norm_phase(const float* xin, const float* gain, const float* mod, bf16_t* H, float* fout) {
    const int lane = threadIdx.x & 63, w = threadIdx.x >> 6;
    for (int rb = blockIdx.x * 8 + w; rb < M_ / 8; rb += gridDim.x * 8) {
        const int r0 = rb * 8, b = r0 >> 12;
        f32x4 a[4], s[4];
#pragma unroll
        for (int i = 0; i < 4; ++i) { const int col = 4 * lane + 256 * i; const f32x4 g = *(const f32x4*)(gain + col);
            if (MOD) { const f32x4 scl = *(const f32x4*)(mod + (size_t)b * NMOD + 1024 + col); a[i] = g * (scl + 1.0f); s[i] = *(const f32x4*)(mod + (size_t)b * NMOD + col); }
            else { a[i] = g; s[i] = (f32x4){0.f, 0.f, 0.f, 0.f}; } }
#pragma unroll 2
        for (int r = 0; r < 8; ++r) {
            const size_t ro = (size_t)(r0 + r) * D_;
            f32x4 x[4]; float ss = 0.f;
#pragma unroll
            for (int i = 0; i < 4; ++i) { x[i] = *(const f32x4*)(xin + ro + 4 * lane + 256 * i); ss += (x[i][0] * x[i][0] + x[i][1] * x[i][1]) + (x[i][2] * x[i][2] + x[i][3] * x[i][3]); }
#pragma unroll
            for (int o = 32; o >= 1; o >>= 1) ss += __shfl_xor(ss, o);
            const float rinv = rsqrtf(ss * (1.0f / D_) + 1e-6f);
#pragma unroll
            for (int i = 0; i < 4; ++i) { const f32x4 h = x[i] * rinv * a[i] + s[i];
                if (MOD) { u32x2 o; o.x = cvt_pk(h[0], h[1]); o.y = cvt_pk(h[2], h[3]); *(u32x2*)(H + ro + 4 * lane + 256 * i) = o; }
                else *(f32x4*)(fout + ro + 4 * lane + 256 * i) = h; }
        }
    }
}

typedef const f32x4 (&AccRef)[2][2][4][2];
struct EpiSwiGLU {
    static constexpr bool PERM = true, AFTER_DRAIN = false;
    bf16_t* O;
    __device__ __forceinline__ void operator()(AccRef acc, const pg8::Unit& u, int wr, int wc, int fr, int fq) const {
        const int row0 = u.pm * 256 + wr * 64 + fr, col0 = u.pn * 128 + wc * 32 + 8 * fq;
#pragma unroll
        for (int ai = 0; ai < 2; ++ai)
#pragma unroll
            for (int m = 0; m < 4; ++m) {
                const f32x4 g0 = acc[ai][0][m][0], g1 = acc[ai][0][m][1], u0 = acc[ai][1][m][0], u1 = acc[ai][1][m][1];
                float v[8];
#pragma unroll
                for (int j = 0; j < 4; ++j) { v[j] = siluf_(g0[j]) * u0[j]; v[4 + j] = siluf_(g1[j]) * u1[j]; }
                u32x4 w; w.x = cvt_pk(v[0], v[1]); w.y = cvt_pk(v[2], v[3]); w.z = cvt_pk(v[4], v[5]); w.w = cvt_pk(v[6], v[7]);
                *(u32x4*)(O + (size_t)(row0 + ai * 128 + m * 16) * DFF + col0) = w;
            }
    }
};
struct EpiRes {
    static constexpr bool PERM = false, AFTER_DRAIN = false;
    const float* xin; float* xout; const float* gate; float coef;
    __device__ __forceinline__ void operator()(AccRef acc, const pg8::Unit& u, int wr, int wc, int fr, int fq) const {
        const int row0 = u.pm * 256 + wr * 64 + fr, col0 = u.pn * 256 + wc * 32 + 4 * fq, b = u.pm >> 4;
        f32x4 gv[2][2];
#pragma unroll
        for (int bj = 0; bj < 2; ++bj)
#pragma unroll
            for (int n = 0; n < 2; ++n) gv[bj][n] = *(const f32x4*)(gate + (size_t)b * NMOD + col0 + bj * 128 + n * 16) * coef;
#pragma unroll
        for (int ai = 0; ai < 2; ++ai)
#pragma unroll
            for (int m = 0; m < 4; ++m) { const size_t off = (size_t)(row0 + ai * 128 + m * 16) * D_ + col0;
#pragma unroll
                for (int bj = 0; bj < 2; ++bj)
#pragma unroll
                    for (int n = 0; n < 2; ++n) { const f32x4 xv = *(const f32x4*)(xin + off + bj * 128 + n * 16); *(f32x4*)(xout + off + bj * 128 + n * 16) = xv + gv[bj][n] * acc[ai][bj][m][n]; } }
    }
};
struct EpiMix {
    static constexpr bool PERM = true, AFTER_DRAIN = false;
    unsigned char* ws;
    __device__ __forceinline__ void operator()(AccRef acc, const pg8::Unit& u, int wr, int wc, int fr, int fq) const {
        const int pn = u.pn; size_t off; int ld, cb; bool sig = false;
        if (pn < 2) { off = WS_HQ; ld = 512; cb = pn * 256; }
        else if (pn < 4) { off = WS_HF; ld = 512; cb = (pn - 2) * 256; }
        else if (pn < 6) { off = WS_HI; ld = 512; cb = (pn - 4) * 256; }
        else if (pn < 8) { off = WS_HG; ld = 512; cb = (pn - 6) * 256; }
        else if (pn == 8) { off = WS_GQ; ld = 256; cb = 0; }
        else if (pn == 9) { off = WS_GK; ld = 256; cb = 0; }
        else if (pn < 12) { off = WS_GV; ld = 512; cb = (pn - 10) * 256; }
        else if (pn < 14) { off = WS_GG; ld = 512; cb = (pn - 12) * 256; }
        else if (pn < 18) { off = WS_RHG; ld = 1024; cb = (pn - 14) * 256; sig = true; }
        else if (pn < 22) { off = WS_RGLA; ld = 1024; cb = (pn - 18) * 256; sig = true; }
        else { off = WS_GKL; ld = 256; cb = 0; }
        bf16_t* base = (bf16_t*)(ws + off);
        const int row0 = u.pm * 256 + wr * 64 + fr, col0 = cb + wc * 32 + 8 * fq;
#pragma unroll
        for (int ai = 0; ai < 2; ++ai)
#pragma unroll
            for (int m = 0; m < 4; ++m) { bf16_t* rowp = base + (size_t)(row0 + ai * 128 + m * 16) * ld + col0;
#pragma unroll
                for (int bj = 0; bj < 2; ++bj) { f32x4 v0 = acc[ai][bj][m][0], v1 = acc[ai][bj][m][1];
                    if (sig) {
#pragma unroll
                        for (int j = 0; j < 4; ++j) { v0[j] = sigmoidf_(v0[j]); v1[j] = sigmoidf_(v1[j]); } }
                    u32x4 w; w.x = cvt_pk(v0[0], v0[1]); w.y = cvt_pk(v0[2], v0[3]); w.z = cvt_pk(v1[0], v1[1]); w.w = cvt_pk(v1[2], v1[3]);
                    *(u32x4*)(rowp + bj * 128) = w; } }
    }
};
template <bool SECOND> struct EpiUp {
    static constexpr bool PERM = true, AFTER_DRAIN = false;
    const bf16_t* R; float* T; bf16_t* O;
    __device__ __forceinline__ void operator()(AccRef acc, const pg8::Unit& u, int wr, int wc, int fr, int fq) const {
        const int row0 = u.pm * 256 + wr * 64 + fr, col0 = u.pn * 256 + wc * 32 + 8 * fq;
#pragma unroll
        for (int ai = 0; ai < 2; ++ai)
#pragma unroll
            for (int m = 0; m < 4; ++m) { const size_t off = (size_t)(row0 + ai * 128 + m * 16) * D_ + col0;
#pragma unroll
                for (int bj = 0; bj < 2; ++bj) { const u32x4 r = *(const u32x4*)(R + off + bj * 128);
                    const f32x4 s0 = (f32x4){bf_lo(r.x), bf_hi(r.x), bf_lo(r.y), bf_hi(r.y)}, s1 = (f32x4){bf_lo(r.z), bf_hi(r.z), bf_lo(r.w), bf_hi(r.w)};
                    f32x4 v0 = s0 * acc[ai][bj][m][0], v1 = s1 * acc[ai][bj][m][1];
                    if (!SECOND) { *(f32x4*)(T + off + bj * 128) = v0; *(f32x4*)(T + off + bj * 128 + 4) = v1; }
                    else { v0 += *(const f32x4*)(T + off + bj * 128); v1 += *(const f32x4*)(T + off + bj * 128 + 4);
                        u32x4 w; w.x = cvt_pk(v0[0], v0[1]); w.y = cvt_pk(v0[2], v0[3]); w.z = cvt_pk(v1[0], v1[1]); w.w = cvt_pk(v1[2], v1[3]);
                        *(u32x4*)(O + off + bj * 128) = w; } } }
    }
};

template <bool HG, bool WANTQ, int RPS>
__device__ __forceinline__ void load_decay(const Params& p, int row_first, int h, int col, float (&lg)[RPS], float (&kv)[RPS], float (&qv)[RPS]) {
    if constexpr (HG) {
        const bf16_t* F = (const bf16_t*)(p.ws + WS_HF) + (size_t)row_first * 512 + h * 128 + col;
        const bf16_t* Q = (const bf16_t*)(p.ws + WS_HQ) + (size_t)row_first * 512 + h * 128 + col;
        const float l0 = p.in[10][h * 128 + col], l1 = p.in[10][512 + h * 128 + col];
        const float lb = __builtin_amdgcn_rcpf(1.0f + __expf(l1 - l0));
        bf16_t fr[RPS], qr[RPS];
#pragma unroll
        for (int r = 0; r < RPS; ++r) { fr[r] = F[(size_t)r * 512]; if (WANTQ) qr[r] = Q[(size_t)r * 512]; }
#pragma unroll
        for (int r = 0; r < RPS; ++r) { const float sg = sigmoidf_(bf2f(fr[r])); const float fg = lb + (1.0f - lb) * sg; lg[r] = __logf(fg); kv[r] = 1.0f - fg; if (WANTQ) qv[r] = siluf_(bf2f(qr[r])); }
    } else {
        const bf16_t* Z = (const bf16_t*)(p.ws + WS_GKL) + (size_t)row_first * 256 + h * 64 + col;
        const bf16_t* Kp = (const bf16_t*)(p.ws + WS_GK) + (size_t)row_first * 256 + h * 64 + col;
        const bf16_t* Q = (const bf16_t*)(p.ws + WS_GQ) + (size_t)row_first * 256 + h * 64 + col;
        const float bg = p.in[9][h * 64 + col];
        bf16_t zr[RPS], kr[RPS], qr[RPS];
#pragma unroll
        for (int r = 0; r < RPS; ++r) { zr[r] = Z[(size_t)r * 256]; kr[r] = Kp[(size_t)r * 256]; if (WANTQ) qr[r] = Q[(size_t)r * 256]; }
#pragma unroll
        for (int r = 0; r < RPS; ++r) { const float z = bf2f(zr[r]) + bg; lg[r] = (fminf(z, 0.f) - __logf(1.0f + __expf(-fabsf(z)))) * (1.0f / 16.0f); kv[r] = bf2f(kr[r]); if (WANTQ) qv[r] = bf2f(qr[r]) * 0.125f; }
    }
}

template <bool HG> __device__ __forceinline__ void chunk_state_phase(const Params& p, LAS unsigned char* lds) {
    constexpr int DK = HG ? 128 : 64, NSEG = 512 / DK, RPS = 64 / NSEG;
    const int tid = threadIdx.x, lane = tid & 63, w = tid >> 6, col = tid & (DK - 1), seg = tid / DK, vcol = tid & 127, vseg = tid >> 7, fr = lane & 15, fq = lane >> 4;
    LAS float* SEG = (LAS float*)(lds + L_SEG);
    const bf16_t* V = (const bf16_t*)(p.ws + (HG ? WS_HI : WS_GV));
    bf16_t* UT = (bf16_t*)(p.ws + (HG ? WS_UHG : WS_UGLA));
    float* DEC = (float*)(p.ws + (HG ? WS_DECHG : WS_DECGLA));
    for (int it = blockIdx.x; it < 1024; it += gridDim.x) {
        const int bh = it >> 6, chunk = it & 63, b = bh >> 2, h = bh & 3, row0 = b * SEQ + chunk * 64;
        float lg[RPS], kv[RPS], qv[RPS];
        load_decay<HG, false, RPS>(p, row0 + seg * RPS, h, col, lg, kv, qv);
        bf16_t vr[16];
        { const bf16_t* vp = V + (size_t)(row0 + vseg * 16) * 512 + h * 128 + vcol;
#pragma unroll
            for (int r = 0; r < 16; ++r) vr[r] = vp[(size_t)r * 512]; }
#pragma unroll
        for (int r = 1; r < RPS; ++r) lg[r] += lg[r - 1];
        SEG[seg * DK + col] = lg[RPS - 1];
        __syncthreads();
        float off = 0.f, tot = 0.f;
#pragma unroll
        for (int s = 0; s < NSEG; ++s) { const float v = SEG[s * DK + col]; if (s < seg) off += v; tot += v; }
        unsigned pk[RPS / 2];
#pragma unroll
        for (int r = 0; r < RPS; r += 2) pk[r / 2] = cvt_pk(kv[r] * __expf(tot - (lg[r] + off)), kv[r + 1] * __expf(tot - (lg[r + 1] + off)));
        { LAS u32x4* dp = (LAS u32x4*)(lds + L_QD + (col * 72 + seg * RPS) * 2);
            dp[0] = (u32x4){pk[0], pk[1], pk[2], pk[3]};
            if constexpr (RPS == 16) dp[1] = (u32x4){pk[4], pk[5], pk[6], pk[7]}; }
        if (seg == 0) DEC[(size_t)it * DK + col] = __expf(tot);
        { LAS u32x4* dp = (LAS u32x4*)(lds + L_VT + (vcol * 72 + vseg * 16) * 2);
            dp[0] = (u32x4){(unsigned)vr[0] | ((unsigned)vr[1] << 16), (unsigned)vr[2] | ((unsigned)vr[3] << 16), (unsigned)vr[4] | ((unsigned)vr[5] << 16), (unsigned)vr[6] | ((unsigned)vr[7] << 16)};
            dp[1] = (u32x4){(unsigned)vr[8] | ((unsigned)vr[9] << 16), (unsigned)vr[10] | ((unsigned)vr[11] << 16), (unsigned)vr[12] | ((unsigned)vr[13] << 16), (unsigned)vr[14] | ((unsigned)vr[15] << 16)}; }
        __syncthreads();
        bf16x8 bfr[2];
#pragma unroll
        for (int ks = 0; ks < 2; ++ks) bfr[ks] = *(const LAS bf16x8*)(lds + L_VT + ((16 * w + fr) * 72 + 32 * ks + 8 * fq) * 2);
#pragma unroll
        for (int kt = 0; kt < DK / 16; ++kt) {
            f32x4 acc = (f32x4){0.f, 0.f, 0.f, 0.f};
#pragma unroll
            for (int ks = 0; ks < 2; ++ks) { const bf16x8 af = *(const LAS bf16x8*)(lds + L_QD + ((16 * kt + fr) * 72 + 32 * ks + 8 * fq) * 2);
                acc = __builtin_amdgcn_mfma_f32_16x16x32_bf16(af, bfr[ks], acc, 0, 0, 0); }
            u32x2 o; o.x = cvt_pk(acc[0], acc[1]); o.y = cvt_pk(acc[2], acc[3]);
            *(u32x2*)(UT + ((size_t)it * 128 + 16 * w + fr) * DK + 16 * kt + 4 * fq) = o;
        }
    }
}

__device__ __forceinline__ void scan_phase(const Params& p) {
    for (int e = blockIdx.x * 512 + threadIdx.x; e < 98304; e += gridDim.x * 512) {
        bf16_t* U; const float* dec; size_t us, dstr;
        if (e < 65536) { const int bh = e >> 12, rem = e & 4095, v = rem >> 5, kq = rem & 31;
            U = (bf16_t*)(p.ws + WS_UHG) + ((size_t)(bh * 64) * 128 + v) * 128 + 4 * kq; dec = (const float*)(p.ws + WS_DECHG) + (size_t)bh * 64 * 128 + 4 * kq; us = 128 * 128; dstr = 128; }
        else { const int e2 = e - 65536, bh = e2 >> 11, rem = e2 & 2047, v = rem >> 4, kq = rem & 15;
            U = (bf16_t*)(p.ws + WS_UGLA) + ((size_t)(bh * 64) * 128 + v) * 64 + 4 * kq; dec = (const float*)(p.ws + WS_DECGLA) + (size_t)bh * 64 * 64 + 4 * kq; us = 128 * 64; dstr = 64; }
        f32x4 S = (f32x4){0.f, 0.f, 0.f, 0.f};
        for (int c0 = 0; c0 < 64; c0 += 8) {
            u32x2 uu[8]; f32x4 dd[8];
#pragma unroll
            for (int j = 0; j < 8; ++j) { uu[j] = *(const u32x2*)(U + (size_t)(c0 + j) * us); dd[j] = *(const f32x4*)(dec + (size_t)(c0 + j) * dstr); }
#pragma unroll
            for (int j = 0; j < 8; ++j) { u32x2 o; o.x = cvt_pk(S[0], S[1]); o.y = cvt_pk(S[2], S[3]); *(u32x2*)(U + (size_t)(c0 + j) * us) = o;
                const f32x4 uv = (f32x4){bf_lo(uu[j].x), bf_hi(uu[j].x), bf_lo(uu[j].y), bf_hi(uu[j].y)}; S = dd[j] * S + uv; }
        }
    }
}

template <bool HG> __device__ __forceinline__ void chunk_out_phase(const Params& p, LAS unsigned char* lds) {
    constexpr int DK = HG ? 128 : 64, NSEG = 512 / DK, RPS = 64 / NSEG, LDQ = DK + 8;
    const int tid = threadIdx.x, lane = tid & 63, w = tid >> 6, col = tid & (DK - 1), seg = tid / DK, vcol = tid & 127, vseg = tid >> 7, fr = lane & 15, fq = lane >> 4;
    LAS float* SEG = (LAS float*)(lds + L_SEG);
    LAS float* SS = (LAS float*)(lds + L_SS);
    const bf16_t* V = (const bf16_t*)(p.ws + (HG ? WS_HI : WS_GV));
    const bf16_t* ST = (const bf16_t*)(p.ws + (HG ? WS_UHG : WS_UGLA));
    bf16_t* G = (bf16_t*)(p.ws + (HG ? WS_HG : WS_GG));
    const f32x4 gn = *(const f32x4*)(p.in[HG ? 11 : 12] + 16 * w + 4 * fq);
    for (int it = blockIdx.x; it < 1024; it += gridDim.x) {
        const int bh = it >> 6, chunk = it & 63, b = bh >> 2, h = bh & 3, row0 = b * SEQ + chunk * 64;
        bf16x8 stf[DK / 32];
#pragma unroll
        for (int ks = 0; ks < DK / 32; ++ks) stf[ks] = *(const bf16x8*)(ST + ((size_t)it * 128 + 16 * w + fr) * DK + 32 * ks + 8 * fq);
        float lg[RPS], kv[RPS], qv[RPS];
        load_decay<HG, true, RPS>(p, row0 + seg * RPS, h, col, lg, kv, qv);
        bf16_t vr[16];
        { const bf16_t* vp = V + (size_t)(row0 + vseg * 16) * 512 + h * 128 + vcol;
#pragma unroll
            for (int r = 0; r < 16; ++r) vr[r] = vp[(size_t)r * 512]; }
#pragma unroll
        for (int r = 1; r < RPS; ++r) lg[r] += lg[r - 1];
        SEG[seg * DK + col] = lg[RPS - 1];
        __syncthreads();
        float off = 0.f, bref = 0.f;
#pragma unroll
        for (int s = 0; s < NSEG; ++s) { const float v = SEG[s * DK + col]; if (s < seg) off += v; if (s < NSEG / 2) bref += v; }
#pragma unroll
        for (int r = 0; r < RPS; r += 2) {
            const float b0 = lg[r] + off, b1 = lg[r + 1] + off; const int t = seg * RPS + r;
            const unsigned qd = cvt_pk(qv[r] * __expf(b0), qv[r + 1] * __expf(b1));
            const unsigned qm = cvt_pk(qv[r] * __expf(fminf(b0 - bref, 40.f)), qv[r + 1] * __expf(fminf(b1 - bref, 40.f)));
            const unsigned km = cvt_pk(kv[r] * __expf(fminf(bref - b0, 40.f)), kv[r + 1] * __expf(fminf(bref - b1, 40.f)));
            *(LAS bf16_t*)(lds + L_QD + (t * LDQ + col) * 2) = (bf16_t)(qd & 0xffffu); *(LAS bf16_t*)(lds + L_QD + ((t + 1) * LDQ + col) * 2) = (bf16_t)(qd >> 16);
            *(LAS bf16_t*)(lds + L_QM + (t * LDQ + col) * 2) = (bf16_t)(qm & 0xffffu); *(LAS bf16_t*)(lds + L_QM + ((t + 1) * LDQ + col) * 2) = (bf16_t)(qm >> 16);
            *(LAS bf16_t*)(lds + L_KM + (t * LDQ + col) * 2) = (bf16_t)(km & 0xffffu); *(LAS bf16_t*)(lds + L_KM + ((t + 1) * LDQ + col) * 2) = (bf16_t)(km >> 16);
        }
        { LAS u32x4* dp = (LAS u32x4*)(lds + L_VT + (vcol * 72 + vseg * 16) * 2);
            dp[0] = (u32x4){(unsigned)vr[0] | ((unsigned)vr[1] << 16), (unsigned)vr[2] | ((unsigned)vr[3] << 16), (unsigned)vr[4] | ((unsigned)vr[5] << 16), (unsigned)vr[6] | ((unsigned)vr[7] << 16)};
            dp[1] = (u32x4){(unsigned)vr[8] | ((unsigned)vr[9] << 16), (unsigned)vr[10] | ((unsigned)vr[11] << 16), (unsigned)vr[12] | ((unsigned)vr[13] << 16), (unsigned)vr[14] | ((unsigned)vr[15] << 16)}; }
        u32x2 gr[4];
#pragma unroll
        for (int tb = 0; tb < 4; ++tb) gr[tb] = *(const u32x2*)(G + (size_t)(row0 + 16 * tb + fr) * 512 + h * 128 + 16 * w + 4 * fq);
        __syncthreads();
#pragma unroll
        for (int j = 0; j < 2; ++j) {
            const int tb = w >> 1, sb = (w & 1) * 2 + j;
            f32x4 acc = (f32x4){0.f, 0.f, 0.f, 0.f};
            if (sb <= tb) {
#pragma unroll
                for (int ks = 0; ks < DK / 32; ++ks) {
                    const bf16x8 af = *(const LAS bf16x8*)(lds + L_KM + ((16 * sb + fr) * LDQ + 32 * ks + 8 * fq) * 2);
                    const bf16x8 bq = *(const LAS bf16x8*)(lds + L_QM + ((16 * tb + fr) * LDQ + 32 * ks + 8 * fq) * 2);
                    acc = __builtin_amdgcn_mfma_f32_16x16x32_bf16(af, bq, acc, 0, 0, 0);
                }
                const int t = 16 * tb + fr, s0 = 16 * sb + 4 * fq;
#pragma unroll
                for (int i = 0; i < 4; ++i) if (s0 + i > t) acc[i] = 0.f;
            }
            u32x2 o; o.x = cvt_pk(acc[0], acc[1]); o.y = cvt_pk(acc[2], acc[3]);
            *(LAS u32x2*)(lds + L_P + ((16 * tb + fr) * 72 + 16 * sb + 4 * fq) * 2) = o;
        }
        __syncthreads();
        bf16x8 vtf[2];
#pragma unroll
        for (int ks = 0; ks < 2; ++ks) vtf[ks] = *(const LAS bf16x8*)(lds + L_VT + ((16 * w + fr) * 72 + 32 * ks + 8 * fq) * 2);
        f32x4 acc[4];
#pragma unroll
        for (int tb = 0; tb < 4; ++tb) {
            acc[tb] = (f32x4){0.f, 0.f, 0.f, 0.f};
#pragma unroll
            for (int ks = 0; ks < DK / 32; ++ks) { const bf16x8 bq = *(const LAS bf16x8*)(lds + L_QD + ((16 * tb + fr) * LDQ + 32 * ks + 8 * fq) * 2);
                acc[tb] = __builtin_amdgcn_mfma_f32_16x16x32_bf16(stf[ks], bq, acc[tb], 0, 0, 0); }
#pragma unroll
            for (int ks = 0; ks < 2; ++ks) { const bf16x8 pf = *(const LAS bf16x8*)(lds + L_P + ((16 * tb + fr) * 72 + 32 * ks + 8 * fq) * 2);
                acc[tb] = __builtin_amdgcn_mfma_f32_16x16x32_bf16(vtf[ks], pf, acc[tb], 0, 0, 0); }
            float ss = (acc[tb][0] * acc[tb][0] + acc[tb][1] * acc[tb][1]) + (acc[tb][2] * acc[tb][2] + acc[tb][3] * acc[tb][3]);
            ss += __shfl_xor(ss, 16); ss += __shfl_xor(ss, 32);
            if (lane < 16) SS[(16 * tb + lane) * 8 + w] = ss;
        }
        __syncthreads();
#pragma unroll
        for (int tb = 0; tb < 4; ++tb) {
            const int t = 16 * tb + fr;
            const f32x4 s0 = *(const LAS f32x4*)(SS + t * 8), s1 = *(const LAS f32x4*)(SS + t * 8 + 4);
            const float tot = ((s0[0] + s0[1]) + (s0[2] + s0[3])) + ((s1[0] + s1[1]) + (s1[2] + s1[3]));
            const float rinv = rsqrtf(tot * (1.0f / 128.0f) + 1e-6f);
            const float g0 = bf_lo(gr[tb].x), g1 = bf_hi(gr[tb].x), g2 = bf_lo(gr[tb].y), g3 = bf_hi(gr[tb].y);
            u32x2 o; o.x = cvt_pk(acc[tb][0] * rinv * gn[0] * siluf_(g0), acc[tb][1] * rinv * gn[1] * siluf_(g1));
            o.y = cvt_pk(acc[tb][2] * rinv * gn[2] * siluf_(g2), acc[tb][3] * rinv * gn[3] * siluf_(g3));
            *(u32x2*)(G + (size_t)(row0 + t) * 512 + h * 128 + 16 * w + 4 * fq) = o;
        }
    }
}

template <class Epi> __device__ __forceinline__ void run_gemm(LAS unsigned char* lds, const bf16_t* A, const bf16_t* Bt, int N, int K, const Epi& E) {
    pg8::Gemm g{A, Bt, M_, N, K}; pg8::StaticOrder S; S.init(M_, N, (int)gridDim.x, (int)blockIdx.x);
    pg8::gemm_phase<Epi, pg8::StaticOrder>(lds, g, S, E, nullptr);
}

__global__ void __launch_bounds__(512, 2) fwd_kernel(Params p) {
    extern __shared__ __attribute__((aligned(16))) unsigned char smem[];
    LAS unsigned char* lds = (LAS unsigned char*)smem;
    cg::grid_group grid = cg::this_grid();
#define GRID_SYNC() do { asm volatile("s_waitcnt vmcnt(0) lgkmcnt(0)" ::: "memory"); grid.sync(); __builtin_amdgcn_fence(__ATOMIC_ACQUIRE, "agent"); asm volatile("s_waitcnt vmcnt(0)" ::: "memory"); } while (0)
    unsigned char* ws = p.ws;
    const float* mod = (const float*)(ws + WS_MOD);
    bf16_t* H = (bf16_t*)(ws + WS_H);
    bf16_t* ACT = (bf16_t*)(ws + WS_ACT);
    float* X = p.out;

    p0_phase(p, lds);
    GRID_SYNC();
    norm_phase<true>(p.in[0], p.in[4], mod, H, nullptr);
    GRID_SYNC();
    run_gemm(lds, H, (const bf16_t*)(ws + WS_WFIN), 2 * DFF, D_, EpiSwiGLU{ACT});
    GRID_SYNC();
    run_gemm(lds, ACT, (const bf16_t*)(ws + WS_WFDOWN), D_, DFF, EpiRes{p.in[0], X, mod + 2 * D_, 0.5f});
    GRID_SYNC();
    norm_phase<true>(X, p.in[4] + D_, mod + 3 * D_, H, nullptr);
    GRID_SYNC();
    run_gemm(lds, H, (const bf16_t*)(ws + WS_WMIX), NMIX, D_, EpiMix{ws});
    GRID_SYNC();
    chunk_state_phase<true>(p, lds); chunk_state_phase<false>(p, lds);
    GRID_SYNC();
    scan_phase(p);
    GRID_SYNC();
    chunk_out_phase<true>(p, lds); chunk_out_phase<false>(p, lds);
    GRID_SYNC();
    run_gemm(lds, (const bf16_t*)(ws + WS_HG), (const bf16_t*)(ws + WS_WUPHG), D_, 512, EpiUp<false>{(const bf16_t*)(ws + WS_RHG), (float*)(ws + WS_T), nullptr});
    run_gemm(lds, (const bf16_t*)(ws + WS_GG), (const bf16_t*)(ws + WS_WUPGLA), D_, 512, EpiUp<true>{(const bf16_t*)(ws + WS_RGLA), (float*)(ws + WS_T), H});
    GRID_SYNC();
    run_gemm(lds, H, (const bf16_t*)(ws + WS_WOUT), D_, D_, EpiRes{X, X, mod + 5 * D_, 1.0f});
    GRID_SYNC();
    norm_phase<true>(X, p.in[4] + 2 * D_, mod + 6 * D_, H, nullptr);
    cvt_ffn(p.in[16], p.in[17], ws);
    GRID_SYNC();
    run_gemm(lds, H, (const bf16_t*)(ws + WS_WFIN), 2 * DFF, D_, EpiSwiGLU{ACT});
    GRID_SYNC();
    run_gemm(lds, ACT, (const bf16_t*)(ws + WS_WFDOWN), D_, DFF, EpiRes{X, X, mod + 8 * D_, 0.5f});
    GRID_SYNC();
    norm_phase<false>(X, p.in[18], nullptr, nullptr, X);
}

extern "C" void kernel_launch(void* const* d_in, const int* in_sizes, int n_in, void* d_out, int out_size, void* d_ws, size_t ws_size, hipStream_t stream) {
    static int grid = 0;
    if (grid == 0) {
        if (n_in != 19 || out_size != M_ * D_ || ws_size < WS_END) { fprintf(stderr, "kernel_launch: unexpected shapes (n_in %d out %d ws %zu)\n", n_in, out_size, ws_size); grid = -1; return; }
        int dev = 0, cus = 0, per_cu = 0;
        (void)hipGetDevice(&dev); (void)hipDeviceGetAttribute(&cus, hipDeviceAttributeMultiprocessorCount, dev);
        if (hipFuncSetAttribute((const void*)fwd_kernel, hipFuncAttributeMaxDynamicSharedMemorySize, LDS_BYTES) != hipSuccess) { fprintf(stderr, "kernel_launch: hipFuncSetAttribute failed\n"); grid = -1; return; }
        if (hipOccupancyMaxActiveBlocksPerMultiprocessor(&per_cu, (const void*)fwd_kernel, 512, LDS_BYTES) != hipSuccess || per_cu < 1) per_cu = 1;
        (void)hipGetLastError();
        grid = cus * per_cu;
    }
    if (grid < 0) return;
    Params p{};
    for (int i = 0; i < 19; ++i) p.in[i] = (const float*)d_in[i];
    p.out = (float*)d_out; p.ws = (unsigned char*)d_ws;
    void* args[] = {&p};
    hipError_t e = hipLaunchCooperativeKernel((const void*)fwd_kernel, dim3(grid), dim3(512), args, LDS_BYTES, stream);
    if (e != hipSuccess) fprintf(stderr, "cooperative launch failed: %s (grid %d)\n", hipGetErrorString(e), grid);
}
```

```cpp
#include <hip/hip_runtime.h>
#include <hip/hip_cooperative_groups.h>
#include <cstdio>
namespace cg = cooperative_groups;
namespace pg8 {
#define PG8_LAS __attribute__((address_space(3)))
typedef unsigned short bf16_t;
typedef short bf16x8 __attribute__((ext_vector_type(8)));
typedef float f32x4 __attribute__((ext_vector_type(4)));
typedef unsigned u32x4 __attribute__((ext_vector_type(4)));
constexpr int BM = 256, BK = 64, HALF = 128, HTB = HALF * BK * 2  , STAGE_BYTES = 8 * HTB, NXCD = 8, WGM = 8;

__host__ __device__ __forceinline__ int lds_byte(int r, int c) { const int st = (r >> 4) * 2 + (c >> 5), rr = r & 15, cc = c & 31, ob = rr * 64 + cc * 2; return st * 1024 + (ob ^ (((ob >> 9) & 1) << 5)); }
__host__ __device__ __forceinline__ void stage_rc(int b, int& R, int& C) { const int st = b / 1024, sb = b % 1024, swz = sb ^ (((sb >> 9) & 1) << 5); R = (st >> 1) * 16 + swz / 64; C = (st & 1) * 32 + (swz % 64) / 2; }
__host__ __device__ __forceinline__ int perm32(int rho) { const int n = rho >> 4, i = rho & 15; return 8 * (i >> 2) + 4 * n + (i & 3); }

struct Unit { int pm, pn; };
struct Gemm { const bf16_t* A; const bf16_t* Bt; int M, N, K; };

struct StaticOrder {
    int nM, nN, nwg, G, c;
    __host__ __device__ void init(int M, int N, int G_, int c_) { nM = M / BM; nN = N / BM; nwg = nM * nN; G = G_; c = c_; }
    __host__ __device__ bool next(int i, Unit& u) const {
        const long L = (long)i * G + c; if (L >= nwg) return false;
        int wgid = (int)L; { const int q = nwg / NXCD, r = nwg % NXCD, xcd = wgid % NXCD, off = wgid / NXCD; wgid = (xcd < r ? xcd * (q + 1) : r * (q + 1) + (xcd - r) * q) + off; }
        const int nig = WGM * nN, gid = wgid / nig, fm = gid * WGM, gsz = (nM - fm) < WGM ? (nM - fm) : WGM;
        u.pm = fm + ((wgid % nig) % gsz); u.pn = (wgid % nig) / gsz; return true;
    }
    __device__ __forceinline__ void a_ready(const Unit&) const {}
    __device__ __forceinline__ void done(const Unit&) const {}
};
struct CountedOrder : StaticOrder {
    const unsigned* ready; unsigned need; unsigned* tmo;
    __device__ __forceinline__ void a_ready(const Unit& u) const {
        if (threadIdx.x < 64) {
            const unsigned long long t0 = __builtin_amdgcn_s_memrealtime(); unsigned polls = 0;
            while ((unsigned)__builtin_amdgcn_readfirstlane(__hip_atomic_load(ready + 64 * u.pm, __ATOMIC_RELAXED, __HIP_MEMORY_SCOPE_AGENT)) < need) {
                if ((++polls & 255u) == 0u && __builtin_amdgcn_readfirstlane(__hip_atomic_load(tmo, __ATOMIC_RELAXED, __HIP_MEMORY_SCOPE_AGENT)) != 0u) break;
                if (__builtin_amdgcn_s_memrealtime() - t0 > 2000000ull) {
                    if (threadIdx.x == 0) { unsigned expect = 0u; __hip_atomic_compare_exchange_strong(tmo + 1, &expect, 0x600u | (unsigned)(u.pm & 0xff), __ATOMIC_RELAXED, __ATOMIC_RELAXED, __HIP_MEMORY_SCOPE_AGENT); __hip_atomic_store(tmo, 1u, __ATOMIC_RELAXED, __HIP_MEMORY_SCOPE_AGENT); }
                    break; }
                __builtin_amdgcn_s_sleep(2); }
            __builtin_amdgcn_fence(__ATOMIC_ACQUIRE, "agent");
            asm volatile("s_waitcnt vmcnt(0)" ::: "memory");
        }
#if !defined(BROKEN_HOOK_NO_BARRIER)
        asm volatile("" ::: "memory"); __builtin_amdgcn_s_barrier(); asm volatile("" ::: "memory");
#endif
    }
};

__device__ __forceinline__ unsigned cvt_pk_bf16(float lo, float hi) { unsigned r; asm volatile("v_cvt_pk_bf16_f32 %0, %1, %2" : "=v"(r) : "v"(lo), "v"(hi)); return r; }
typedef float f32x2 __attribute__((ext_vector_type(2)));
__device__ __forceinline__ f32x2 gelu_pk(f32x2 v) {
    const f32x2 av = __builtin_elementwise_abs(v), d = av * 0.2316418882f + 1.0f;
    f32x2 t; t.x = __builtin_amdgcn_rcpf(d.x); t.y = __builtin_amdgcn_rcpf(d.y);
    f32x2 q = t * 0.5307027145f + (-0.7265760135f); q = q * t + 0.7107068705f; q = q * t + (-0.142248368f); q = q * t + 0.127414796f; q = q * t;
    const f32x2 s = (v * v) * (-0.72134752044f);
    f32x2 e; e.x = __builtin_amdgcn_exp2f(s.x); e.y = __builtin_amdgcn_exp2f(s.y);
    const f32x2 m = v * (q * e), r = v - m;
    f32x2 o; o.x = v.x < 0.f ? m.x : r.x; o.y = v.y < 0.f ? m.y : r.y; return o;
}

struct EpiF32 {
    static constexpr bool PERM = false, AFTER_DRAIN = false;
    float* C; int ldc; const float* bias;
    __device__ __forceinline__ void operator()(const f32x4 (&acc)[2][2][4][2], const Unit& u, int wr, int wc, int fr, int fq) const {
        const int row0 = u.pm * BM + wr * 64 + fr, col0 = u.pn * BM + wc * 32 + 4 * fq;
        f32x4 bv[2][2];
#pragma unroll
        for (int bj = 0; bj < 2; ++bj)
#pragma unroll
            for (int n = 0; n < 2; ++n) bv[bj][n] = bias ? *(const f32x4*)(bias + col0 + bj * HALF + n * 16) : (f32x4){0.f, 0.f, 0.f, 0.f};
#pragma unroll
        for (int ai = 0; ai < 2; ++ai)
#pragma unroll
            for (int m = 0; m < 4; ++m) { float* rowp = C + (size_t)(row0 + ai * HALF + m * 16) * ldc + col0;
#pragma unroll
                for (int bj = 0; bj < 2; ++bj)
#pragma unroll
                    for (int n = 0; n < 2; ++n) *(f32x4*)(rowp + bj * HALF + n * 16) = acc[ai][bj][m][n] + bv[bj][n]; }
    }
};
template <int ACT  > struct EpiBf16 {
    static constexpr bool PERM = true, AFTER_DRAIN = false;
    bf16_t* O; int ldc; const float* bias; int split_cols; size_t split_stride;
    __device__ __forceinline__ void operator()(const f32x4 (&acc)[2][2][4][2], const Unit& u, int wr, int wc, int fr, int fq) const {
        const int row0 = u.pm * BM + wr * 64 + fr; int colt = u.pn * BM; bf16_t* base = O;
        if (split_cols) { const int t = colt / split_cols; base += (size_t)t * split_stride; colt -= t * split_cols; }
        const int col0 = colt + wc * 32 + 8 * fq, bcol0 = u.pn * BM + wc * 32 + 8 * fq;
        f32x4 bv[2][2];
#pragma unroll
        for (int bj = 0; bj < 2; ++bj)
#pragma unroll
            for (int n = 0; n < 2; ++n) bv[bj][n] = bias ? *(const f32x4*)(bias + bcol0 + bj * HALF + 4 * n) : (f32x4){0.f, 0.f, 0.f, 0.f};
#pragma unroll
        for (int ai = 0; ai < 2; ++ai)
#pragma unroll
            for (int m = 0; m < 4; ++m) { bf16_t* rowp = base + (size_t)(row0 + ai * HALF + m * 16) * ldc + col0;
#pragma unroll
                for (int bj = 0; bj < 2; ++bj) { f32x4 v0 = acc[ai][bj][m][0] + bv[bj][0], v1 = acc[ai][bj][m][1] + bv[bj][1];
                    if (ACT == 1) { f32x2 a = gelu_pk((f32x2){v0[0], v0[1]}), b = gelu_pk((f32x2){v0[2], v0[3]}), c = gelu_pk((f32x2){v1[0], v1[1]}), d = gelu_pk((f32x2){v1[2], v1[3]});
                        v0 = (f32x4){a.x, a.y, b.x, b.y}; v1 = (f32x4){c.x, c.y, d.x, d.y}; }
                    if (ACT == 2) {
#pragma unroll
                        for (int j = 0; j < 4; ++j) { v0[j] = 0.5f * v0[j] * (1.0f + erff(v0[j] * 0.70710678f)); v1[j] = 0.5f * v1[j] * (1.0f + erff(v1[j] * 0.70710678f)); } }
                    u32x4 w; w.x = cvt_pk_bf16(v0[0], v0[1]); w.y = cvt_pk_bf16(v0[2], v0[3]); w.z = cvt_pk_bf16(v1[0], v1[1]); w.w = cvt_pk_bf16(v1[2], v1[3]);
                    *(u32x4*)(rowp + bj * HALF) = w; } }
    }
};

struct PanelStats {
    unsigned* xbuf;
    unsigned* cnt;
    unsigned* tmo;
    int ntn; float eps;
    unsigned code;
    __device__ __forceinline__ bool run(const f32x4 (&v)[2][2][4][2], const Unit& u, int wr, int wc, int fr, int fq, PG8_LAS unsigned char* lds, int wid, int lane) const {
        typedef float f32x2v __attribute__((ext_vector_type(2)));
        PG8_LAS f32x2v* P = (PG8_LAS f32x2v*)lds;
        PG8_LAS f32x2v* S = (PG8_LAS f32x2v*)(lds + 8192);
        PG8_LAS unsigned* flag = (PG8_LAS unsigned*)(lds + 8192 + 2048);
#pragma unroll
        for (int ai = 0; ai < 2; ++ai)
#pragma unroll
            for (int m = 0; m < 4; ++m) {
                float s = 0.f;
#pragma unroll
                for (int bj = 0; bj < 2; ++bj)
#pragma unroll
                    for (int n = 0; n < 2; ++n) { const f32x4 x = v[ai][bj][m][n]; s += (x[0] + x[1]) + (x[2] + x[3]); }
                s += __shfl_xor(s, 16); s += __shfl_xor(s, 32);
                const float mw = s * (1.0f / 64.0f); float q = 0.f;
#pragma unroll
                for (int bj = 0; bj < 2; ++bj)
#pragma unroll
                    for (int n = 0; n < 2; ++n) { const f32x4 d = v[ai][bj][m][n] - mw; q += (d[0] * d[0] + d[1] * d[1]) + (d[2] * d[2] + d[3] * d[3]); }
                q += __shfl_xor(q, 16); q += __shfl_xor(q, 32);
                if (fq == 0) P[(ai * HALF + wr * 64 + m * 16 + fr) * 4 + wc] = (f32x2v){mw, q};
            }
        asm volatile("s_waitcnt lgkmcnt(0)" ::: "memory"); __builtin_amdgcn_s_barrier(); asm volatile("" ::: "memory");
#if defined(BROKEN_NO_WAIT)
        if (blockIdx.x >= 64) { const long long t0 = clock64(); while (clock64() - t0 < 60000) __builtin_amdgcn_s_sleep(8); }
#endif
        const int row = wid * 32 + (lane & 31);
        if (lane < 32) {
            const f32x2v a = P[row * 4 + 0], b = P[row * 4 + 1], c = P[row * 4 + 2], d = P[row * 4 + 3];
            const float mt = (a.x + b.x + c.x + d.x) * 0.25f;
            const float da = a.x - mt, db = b.x - mt, dc = c.x - mt, dd = d.x - mt;
            const float m2 = (a.y + b.y) + (c.y + d.y) + 64.0f * ((da * da + db * db) + (dc * dc + dd * dd));
            unsigned long long* slot = (unsigned long long*)xbuf + ((size_t)(u.pm * BM + row) * 4 + u.pn);
            __hip_atomic_store(slot, ((unsigned long long)__float_as_uint(m2) << 32) | __float_as_uint(mt), __ATOMIC_RELAXED, __HIP_MEMORY_SCOPE_AGENT);
        }
        asm volatile("s_waitcnt vmcnt(0)" ::: "memory");
        if (lane == 0) __hip_atomic_fetch_add(cnt + 64 * u.pm, 1u, __ATOMIC_RELAXED, __HIP_MEMORY_SCOPE_AGENT);
        if (wid == 0) {
            bool dead = false; const unsigned long long t0 = __builtin_amdgcn_s_memrealtime(); const unsigned want = 8u * (unsigned)ntn;
            for (;;) {
#if defined(BROKEN_NO_WAIT)
                break;
#endif
                if ((unsigned)__builtin_amdgcn_readfirstlane(__hip_atomic_load(cnt + 64 * u.pm, __ATOMIC_RELAXED, __HIP_MEMORY_SCOPE_AGENT)) >= want) break;
                if (__builtin_amdgcn_s_memrealtime() - t0 > 2000000ull) {
                    if (lane == 0) { unsigned expect = 0u; __hip_atomic_compare_exchange_strong(tmo + 1, &expect, code | (unsigned)(u.pm & 0xff), __ATOMIC_RELAXED, __ATOMIC_RELAXED, __HIP_MEMORY_SCOPE_AGENT);
                                     __hip_atomic_store(tmo, 1u, __ATOMIC_RELAXED, __HIP_MEMORY_SCOPE_AGENT); }
                    dead = true; break; }
                __builtin_amdgcn_s_sleep(2);
            }
            __builtin_amdgcn_fence(__ATOMIC_ACQUIRE, "agent");
            if (lane == 0) flag[0] = dead ? 1u : 0u;
        }
        asm volatile("s_waitcnt vmcnt(0) lgkmcnt(0)" ::: "memory"); __builtin_amdgcn_s_barrier(); asm volatile("" ::: "memory");
        const bool bad = flag[0] != 0u;
        if (lane < 32) {
            const unsigned long long* slot = (const unsigned long long*)xbuf + (size_t)(u.pm * BM + row) * 4; float mt[4], m2[4]; float ms = 0.f;
#pragma unroll
            for (int t = 0; t < 4; ++t) { if (t < ntn) { const unsigned long long w = __hip_atomic_load(slot + t, __ATOMIC_RELAXED, __HIP_MEMORY_SCOPE_AGENT); mt[t] = __uint_as_float((unsigned)w); m2[t] = __uint_as_float((unsigned)(w >> 32)); } else { mt[t] = 0.f; m2[t] = 0.f; } ms += mt[t]; }
            const float mean = ms / (float)ntn; float q = 0.f;
#pragma unroll
            for (int t = 0; t < 4; ++t) if (t < ntn) { const float dm = mt[t] - mean; q += m2[t] + 256.0f * dm * dm; }
            S[row] = (f32x2v){mean, 1.0f / sqrtf(q / (256.0f * (float)ntn) + eps)};
        }
        asm volatile("s_waitcnt lgkmcnt(0)" ::: "memory"); __builtin_amdgcn_s_barrier(); asm volatile("" ::: "memory");
        return bad;
    }
};
struct EpiLnRes {
    static constexpr bool PERM = false, AFTER_DRAIN = true;
    const float* base; float* out; int ldc; const float* bias; PanelStats st; unsigned poison;
    __device__ __forceinline__ void refuse(size_t i0, size_t stride, int M, int N) const { const float q = __builtin_nanf(""); for (size_t i = i0; i < (size_t)M * N; i += stride) out[(i / N) * ldc + i % N] = q;
        if (i0 == 0) { unsigned expect = 0u; __hip_atomic_compare_exchange_strong(st.tmo + 1, &expect, 0x7f0u, __ATOMIC_RELAXED, __ATOMIC_RELAXED, __HIP_MEMORY_SCOPE_AGENT); __hip_atomic_store(st.tmo, 1u, __ATOMIC_RELAXED, __HIP_MEMORY_SCOPE_AGENT); } }
    __device__ __forceinline__ void fused(f32x4 (&acc)[2][2][4][2], const Unit& u, int wr, int wc, int fr, int fq, PG8_LAS unsigned char* lds, int wid, int lane) const {
        typedef float f32x2v __attribute__((ext_vector_type(2)));
        const PG8_LAS f32x2v* S = (const PG8_LAS f32x2v*)(lds + 8192);
        const int col0 = u.pn * BM + wc * 32 + 4 * fq;
#pragma unroll
        for (int bj = 0; bj < 2; ++bj)
#pragma unroll
            for (int n = 0; n < 2; ++n) { const f32x4 bv = bias ? *(const f32x4*)(bias + col0 + bj * HALF + n * 16) : (f32x4){0.f, 0.f, 0.f, 0.f};
#pragma unroll
                for (int ai = 0; ai < 2; ++ai)
#pragma unroll
                    for (int m = 0; m < 4; ++m) acc[ai][bj][m][n] += bv; }
        const bool bad = st.run(acc, u, wr, wc, fr, fq, lds, wid, lane) || poison != 0u;
        const float qnan = __builtin_nanf("");
#pragma unroll
        for (int ai = 0; ai < 2; ++ai)
#pragma unroll
            for (int m = 0; m < 4; ++m) { const int r = ai * HALF + wr * 64 + m * 16 + fr; const f32x2v sr = S[r]; const size_t off = (size_t)(u.pm * BM + r) * ldc + col0;
#pragma unroll
                for (int bj = 0; bj < 2; ++bj)
#pragma unroll
                    for (int n = 0; n < 2; ++n) { const f32x4 bs = *(const f32x4*)(base + off + bj * HALF + n * 16); f32x4 o = bs + (acc[ai][bj][m][n] - sr.x) * sr.y;
                        if (bad) o = (f32x4){qnan, qnan, qnan, qnan}; *(f32x4*)(out + off + bj * HALF + n * 16) = o; }
                asm volatile("" ::: "memory"); }
    }
};
struct EpiLnResLn {
    static constexpr bool PERM = false, AFTER_DRAIN = true;
    const float* base; float* out; bf16_t* xn; int ldc; const float* bias; PanelStats st1, st2; unsigned poison;
    __device__ __forceinline__ void refuse(size_t i0, size_t stride, int M, int N) const { const float q = __builtin_nanf(""); for (size_t i = i0; i < (size_t)M * N; i += stride) { const size_t o = (i / N) * ldc + i % N; out[o] = q; xn[o] = (bf16_t)0x7fc0u; }
        if (i0 == 0) { unsigned expect = 0u; __hip_atomic_compare_exchange_strong(st1.tmo + 1, &expect, 0x7f0u, __ATOMIC_RELAXED, __ATOMIC_RELAXED, __HIP_MEMORY_SCOPE_AGENT); __hip_atomic_store(st1.tmo, 1u, __ATOMIC_RELAXED, __HIP_MEMORY_SCOPE_AGENT); } }
    __device__ __forceinline__ void fused(f32x4 (&acc)[2][2][4][2], const Unit& u, int wr, int wc, int fr, int fq, PG8_LAS unsigned char* lds, int wid, int lane) const {
        typedef float f32x2v __attribute__((ext_vector_type(2))); typedef unsigned u32x2v __attribute__((ext_vector_type(2)));
        const PG8_LAS f32x2v* S = (const PG8_LAS f32x2v*)(lds + 8192);
        const int col0 = u.pn * BM + wc * 32 + 4 * fq;
#pragma unroll
        for (int bj = 0; bj < 2; ++bj)
#pragma unroll
            for (int n = 0; n < 2; ++n) { const f32x4 bv = bias ? *(const f32x4*)(bias + col0 + bj * HALF + n * 16) : (f32x4){0.f, 0.f, 0.f, 0.f};
#pragma unroll
                for (int ai = 0; ai < 2; ++ai)
#pragma unroll
                    for (int m = 0; m < 4; ++m) acc[ai][bj][m][n] += bv; }
        bool bad = st1.run(acc, u, wr, wc, fr, fq, lds, wid, lane) || poison != 0u;
        const float qnan = __builtin_nanf("");
#pragma unroll
        for (int ai = 0; ai < 2; ++ai)
#pragma unroll
            for (int m = 0; m < 4; ++m) { const int r = ai * HALF + wr * 64 + m * 16 + fr; const f32x2v sr = S[r]; const size_t off = (size_t)(u.pm * BM + r) * ldc + col0;
#pragma unroll
                for (int bj = 0; bj < 2; ++bj)
#pragma unroll
                    for (int n = 0; n < 2; ++n) { const f32x4 bs = *(const f32x4*)(base + off + bj * HALF + n * 16); acc[ai][bj][m][n] = bs + (acc[ai][bj][m][n] - sr.x) * sr.y; }
                asm volatile("" : "+v"(acc[ai][0][m][0]), "+v"(acc[ai][0][m][1]), "+v"(acc[ai][1][m][0]), "+v"(acc[ai][1][m][1]));
                if (m & 1) asm volatile("" ::: "memory"); }
        const bool bad1 = bad;
        bad = st2.run(acc, u, wr, wc, fr, fq, lds, wid, lane) || bad;
#pragma unroll
        for (int ai = 0; ai < 2; ++ai)
#pragma unroll
            for (int m = 0; m < 4; ++m) { const int r = ai * HALF + wr * 64 + m * 16 + fr; const f32x2v sr = S[r]; const size_t off = (size_t)(u.pm * BM + r) * ldc + col0;
#pragma unroll
                for (int bj = 0; bj < 2; ++bj)
#pragma unroll
                    for (int n = 0; n < 2; ++n) { const f32x4 x1 = acc[ai][bj][m][n]; *(f32x4*)(out + off + bj * HALF + n * 16) = bad1 ? (f32x4){qnan, qnan, qnan, qnan} : x1;
                        const f32x4 o = (x1 - sr.x) * sr.y; u32x2v w; w.x = cvt_pk_bf16(o[0], o[1]); w.y = cvt_pk_bf16(o[2], o[3]);
                        if (bad) { w.x = 0x7fc07fc0u; w.y = 0x7fc07fc0u; } *(u32x2v*)(xn + off + bj * HALF + n * 16) = w; }
                asm volatile("" ::: "memory"); }
    }
};

template <class Epi, class Sched, bool STAMP = false>
__device__ __forceinline__ void gemm_phase(PG8_LAS unsigned char* lds, const Gemm g, const Sched& S, const Epi& E, unsigned long long* stamps) {
    const int tid = threadIdx.x, wid = __builtin_amdgcn_readfirstlane(tid >> 6), lane = tid & 63, wr = wid >> 2, wc = wid & 3, fr = lane & 15, fq = lane >> 4;
    const int K = g.K, nt = K / BK;
    int ts_lo = 0, ts_hi = 0, nts = 0; const unsigned long long rt_entry = STAMP ? (unsigned long long)wall_clock64() : 0ull;
#define PG8_STAMP() do { if (STAMP && wid == 0 && nts < 64) { const unsigned long long _c = (unsigned long long)clock64(); \
        ts_lo = (lane == nts) ? (int)(unsigned)_c : ts_lo; ts_hi = (lane == nts) ? (int)(unsigned)(_c >> 32) : ts_hi; ++nts; } } while (0)
    PG8_STAMP();
    unsigned voffA[2], voffB[2];
#pragma unroll
    for (int i = 0; i < 2; ++i) { int R, C; stage_rc(tid * 16 + i * 8192, R, C); const int Rb = Epi::PERM ? ((R & ~31) + perm32(R & 31)) : R;
        voffA[i] = (unsigned)(R * K + C) * 2u; voffB[i] = (unsigned)(Rb * K + C) * 2u; }
    const size_t kstep = (size_t)(BK * 2);
    const size_t hstep = (size_t)HALF * K * 2;
    const size_t tstep = 2 * hstep;
    const unsigned ldsw = (unsigned)wid * 1024u;
    const int aoff = lds_byte(wr * 64 + fr, fq * 8), boff = lds_byte(wc * 32 + fr, fq * 8);
#define PG8_SA(b, h) (((b) * 2 + (h)) * HTB)
#define PG8_SB(b, h) ((4 + (b) * 2 + (h)) * HTB)
#define PG8_STAGE(bufoff, gbase, voff) do { _Pragma("unroll") for (int _i = 0; _i < 2; ++_i) \
        __builtin_amdgcn_global_load_lds((const unsigned*)((const char*)(gbase) + (voff)[_i]), (PG8_LAS unsigned*)(lds + (bufoff) + ldsw + _i * 8192), 16, 0, 0); } while (0)
#define PG8_LDA(dst, b, h) do { _Pragma("unroll") for (int m = 0; m < 4; ++m) _Pragma("unroll") for (int k = 0; k < 2; ++k) dst[m][k] = *(const PG8_LAS bf16x8*)(lds + PG8_SA(b, h) + aoff + m * 2048 + k * 1024); } while (0)
#define PG8_LDB(dst, b, h) do { _Pragma("unroll") for (int n = 0; n < 2; ++n) _Pragma("unroll") for (int k = 0; k < 2; ++k) dst[n][k] = *(const PG8_LAS bf16x8*)(lds + PG8_SB(b, h) + boff + n * 2048 + k * 1024); } while (0)
#define PG8_MMA(ai, bj, At, Bt) do { __builtin_amdgcn_s_setprio(1); _Pragma("unroll") for (int m = 0; m < 4; ++m) _Pragma("unroll") for (int n = 0; n < 2; ++n) _Pragma("unroll") for (int k = 0; k < 2; ++k) \
        acc[ai][bj][m][n] = __builtin_amdgcn_mfma_f32_16x16x32_bf16(Bt[n][k], At[m][k], acc[ai][bj][m][n], 0, 0, 0); __builtin_amdgcn_s_setprio(0); } while (0)
#define PG8_WAIT_V(n) asm volatile("s_waitcnt vmcnt(" #n ")" ::: "memory")
#define PG8_WAIT_L(n) asm volatile("s_waitcnt lgkmcnt(" #n ")" ::: "memory")
#define PG8_BAR __builtin_amdgcn_s_barrier()
#define PG8_SCHED __builtin_amdgcn_sched_barrier(0)
    Unit cur, nxt; int ui = 0;
    if (!S.next(0, cur)) return;
    f32x4 acc[2][2][4][2];
#pragma unroll
    for (int a = 0; a < 2; ++a)
#pragma unroll
        for (int b = 0; b < 2; ++b)
#pragma unroll
            for (int m = 0; m < 4; ++m)
#pragma unroll
                for (int n = 0; n < 2; ++n) acc[a][b][m][n] = (f32x4){0.f, 0.f, 0.f, 0.f};
    bf16x8 At[4][2], B0[2][2], B1[2][2];
    const char* cA = (const char*)g.A + (size_t)cur.pm * tstep; const char* cB = (const char*)g.Bt + (size_t)cur.pn * tstep;
    S.a_ready(cur);
    PG8_STAGE(PG8_SB(0, 0), cB, voffB); PG8_STAGE(PG8_SA(0, 0), cA, voffA); PG8_STAGE(PG8_SB(0, 1), cB + hstep, voffB); PG8_STAGE(PG8_SA(0, 1), cA + hstep, voffA);
    if (wr == 1) PG8_BAR;
    PG8_WAIT_V(4); PG8_BAR;
    PG8_STAGE(PG8_SB(1, 0), cB + kstep, voffB); PG8_STAGE(PG8_SA(1, 0), cA + kstep, voffA); PG8_STAGE(PG8_SB(1, 1), cB + hstep + kstep, voffB);
    PG8_WAIT_V(6); PG8_BAR;
    PG8_STAMP();
    for (;;) {
        const bool has_next = S.next(ui + 1, nxt);
        const char* nA = has_next ? (const char*)g.A + (size_t)nxt.pm * tstep : cA; const char* nB = has_next ? (const char*)g.Bt + (size_t)nxt.pn * tstep : cB;
        for (int t = 0; t < nt; t += 2) {
            const bool last = (t == nt - 2);
            const char* a1 = cA + (size_t)(t + 1) * kstep;
            const char* a2 = last ? nA : cA + (size_t)(t + 2) * kstep; const char* b2 = last ? nB : cB + (size_t)(t + 2) * kstep;
            const char* a3 = a2 + kstep; const char* b3 = b2 + kstep;
            if (last && has_next) S.a_ready(nxt);
            PG8_LDB(B0, 0, 0); PG8_SCHED; PG8_LDA(At, 0, 0); PG8_STAGE(PG8_SA(1, 1), a1 + hstep, voffA);
            PG8_WAIT_L(8); PG8_BAR; PG8_WAIT_L(0); PG8_MMA(0, 0, At, B0); PG8_BAR; PG8_SCHED;
            PG8_LDB(B1, 0, 1); PG8_STAGE(PG8_SB(0, 0), b2, voffB);
            PG8_BAR; PG8_WAIT_L(0); PG8_MMA(0, 1, At, B1); PG8_BAR;
            PG8_LDA(At, 0, 1); PG8_STAGE(PG8_SA(0, 0), a2, voffA);
            PG8_BAR; PG8_WAIT_L(0); PG8_MMA(1, 0, At, B0); PG8_BAR; PG8_SCHED;
            PG8_STAGE(PG8_SB(0, 1), b2 + hstep, voffB);
            PG8_WAIT_V(6); PG8_BAR; PG8_MMA(1, 1, At, B1); PG8_BAR;
            PG8_LDB(B0, 1, 0); PG8_SCHED; PG8_LDA(At, 1, 0); PG8_STAGE(PG8_SA(0, 1), a2 + hstep, voffA);
            PG8_WAIT_L(8); PG8_BAR; PG8_WAIT_L(0); PG8_MMA(0, 0, At, B0); PG8_BAR; PG8_SCHED;
            PG8_LDB(B1, 1, 1); PG8_STAGE(PG8_SB(1, 0), b3, voffB);
            PG8_BAR; PG8_WAIT_L(0); PG8_MMA(0, 1, At, B1); PG8_BAR;
            PG8_LDA(At, 1, 1); PG8_STAGE(PG8_SA(1, 0), a3, voffA);
            PG8_BAR; PG8_WAIT_L(0); PG8_MMA(1, 0, At, B0); PG8_BAR; PG8_SCHED;
            PG8_STAGE(PG8_SB(1, 1), b3 + hstep, voffB);
            PG8_WAIT_V(6); PG8_BAR; PG8_MMA(1, 1, At, B1); PG8_BAR;
        }
        PG8_STAMP();
        if constexpr (!Epi::AFTER_DRAIN) { E(acc, cur, wr, wc, fr, fq); S.done(cur); }
        PG8_STAMP();
        if (!has_next) break;
#pragma unroll
        for (int a = 0; a < 2; ++a)
#pragma unroll
            for (int b = 0; b < 2; ++b)
#pragma unroll
                for (int m = 0; m < 4; ++m)
#pragma unroll
                    for (int n = 0; n < 2; ++n) acc[a][b][m][n] = (f32x4){0.f, 0.f, 0.f, 0.f};
        cur = nxt; cA = nA; cB = nB; ++ui;
    }
    PG8_WAIT_V(0);
    if (wr == 0) PG8_BAR;
    PG8_BAR;
    if constexpr (Epi::AFTER_DRAIN) { E.fused(acc, cur, wr, wc, fr, fq, lds, wid, lane); S.done(cur); }
    PG8_STAMP();
    if (STAMP && wid == 0) { stamps[lane] = lane < nts ? (((unsigned long long)(unsigned)ts_hi << 32) | (unsigned)ts_lo) : 0ull;
        if (lane == 62) stamps[62] = rt_entry; if (lane == 63) stamps[63] = (unsigned long long)wall_clock64(); }
#undef PG8_STAMP
#undef PG8_SA
#undef PG8_SB
#undef PG8_STAGE
#undef PG8_LDA
#undef PG8_LDB
#undef PG8_MMA
#undef PG8_WAIT_V
#undef PG8_WAIT_L
#undef PG8_BAR
#undef PG8_SCHED
}
}

#define LAS __attribute__((address_space(3)))
typedef unsigned short bf16_t;
typedef short bf16x8 __attribute__((ext_vector_type(8)));
typedef float f32x4 __attribute__((ext_vector_type(4)));
typedef unsigned u32x4 __attribute__((ext_vector_type(4)));
typedef unsigned u32x2 __attribute__((ext_vector_type(2)));

constexpr int M_ = 16384, D_ = 1024, DFF = 2816, SEQ = 4096, NMIX = 5888, NMOD = 9216;
constexpr size_t MiB = (size_t)1 << 20;
constexpr size_t WS_WMIX = 0, WS_WUPHG = 11 * MiB + MiB / 2, WS_WUPGLA = WS_WUPHG + MiB, WS_WOUT = WS_WUPGLA + MiB,
                 WS_MOD = 15 * MiB + MiB / 2, WS_DECHG = WS_MOD + 256 * 1024, WS_DECGLA = WS_DECHG + 512 * 1024,
                 WS_WFIN = 16 * MiB + MiB / 2, WS_WFDOWN = WS_WFIN + 11 * MiB, WS_H = 33 * MiB, WS_ACT = 65 * MiB,
                 WS_UHG = WS_WFIN, WS_UGLA = WS_UHG + 32 * MiB,
                 WS_HQ = 65 * MiB, WS_HF = 81 * MiB, WS_HI = 97 * MiB, WS_GQ = 113 * MiB, WS_GK = 121 * MiB, WS_GKL = 129 * MiB,
                 WS_GV = 137 * MiB, WS_HG = 153 * MiB, WS_GG = 169 * MiB, WS_RHG = 185 * MiB, WS_RGLA = 217 * MiB, WS_END = 249 * MiB,
                 WS_T = 65 * MiB;
constexpr int LDS_BYTES = 131072 + 16;
constexpr size_t WS_BAR = 250 * MiB;
constexpr int L_QD = 0, L_QM = 18432, L_KM = 36864, L_VT = 55296, L_P = 73728, L_SEG = 82944, L_SS = 87040;

struct Params { const float* in[19]; float* out; unsigned char* ws; };

typedef float f32x2_t __attribute__((ext_vector_type(2)));
typedef __bf16 bf16x2_t __attribute__((ext_vector_type(2)));
__device__ __forceinline__ unsigned cvt_pk(float lo, float hi) { const f32x2_t v = {lo, hi}; return __builtin_bit_cast(unsigned, __builtin_convertvector(v, bf16x2_t)); }
__device__ __forceinline__ float bf_lo(unsigned w) { return __uint_as_float(w << 16); }
__device__ __forceinline__ float bf_hi(unsigned w) { return __uint_as_float(w & 0xffff0000u); }
__device__ __forceinline__ float bf2f(bf16_t h) { return __uint_as_float(((unsigned)h) << 16); }
__device__ __forceinline__ float sigmoidf_(float x) { return __builtin_amdgcn_rcpf(1.0f + __expf(-x)); }
__device__ __forceinline__ float siluf_(float x) { return x * sigmoidf_(x); }

template <class F> __device__ __forceinline__ void cvt_tiles(const float* __restrict__ src, int ld, bf16_t* __restrict__ dst, int N, int K, F srccol) {
    const int tid = threadIdx.x, ntk = K >> 6, nt = (N >> 6) * ntk;
    for (int t = blockIdx.x; t < nt; t += gridDim.x) {
        const int tn = t / ntk, tk = t - tn * ntk, n = tn * 64 + (tid & 63), k = tk * 64 + 8 * (tid >> 6);
        const float* p = src + (size_t)k * ld + srccol(n);
        float v[8];
#pragma unroll
        for (int i = 0; i < 8; ++i) v[i] = p[(size_t)i * ld];
        u32x4 w; w.x = cvt_pk(v[0], v[1]); w.y = cvt_pk(v[2], v[3]); w.z = cvt_pk(v[4], v[5]); w.w = cvt_pk(v[6], v[7]);
        *(u32x4*)(dst + (size_t)n * K + k) = w;
    }
}
__device__ __forceinline__ void cvt_ffn(const float* w_in, const float* w_down, unsigned char* ws) {
    cvt_tiles(w_in, 2 * DFF, (bf16_t*)(ws + WS_WFIN), 2 * DFF, D_, [](int n) { const int j = (n >> 8) * 128 + (n & 127); return (n & 128) ? DFF + j : j; });
    cvt_tiles(w_down, D_, (bf16_t*)(ws + WS_WFDOWN), D_, DFF, [](int n) { return n; });
}
__device__ __forceinline__ void p0_phase(const Params& p, LAS unsigned char* lds) {
    const int tid = threadIdx.x;
    cvt_ffn(p.in[5], p.in[6], p.ws);
    cvt_tiles(p.in[7], 5648, (bf16_t*)(p.ws + WS_WMIX), 5632, D_, [](int n) { return n < 3584 ? n : n + 16; });
    cvt_tiles(p.in[13], D_, (bf16_t*)(p.ws + WS_WUPHG), D_, 512, [](int n) { return n; });
    cvt_tiles(p.in[14], D_, (bf16_t*)(p.ws + WS_WUPGLA), D_, 512, [](int n) { return n; });
    cvt_tiles(p.in[15], D_, (bf16_t*)(p.ws + WS_WOUT), D_, D_, [](int n) { return n; });
    {
        const float* wmix = p.in[7]; const float* wgk = p.in[8]; bf16_t* dst = (bf16_t*)(p.ws + WS_WMIX);
        for (int idx = blockIdx.x * 512 + tid; idx < 256 * 128; idx += gridDim.x * 512) {
            const int j = idx & 255, k0 = (idx >> 8) * 8;
            float wj[16];
#pragma unroll
            for (int r = 0; r < 16; ++r) wj[r] = wgk[r * 256 + j];
            float v[8];
#pragma unroll
            for (int i = 0; i < 8; ++i) { const float* wr = wmix + (size_t)(k0 + i) * 5648 + 3584; float s = 0.f;
#pragma unroll
                for (int r = 0; r < 16; ++r) s += wr[r] * wj[r];
                v[i] = s; }
            u32x4 w; w.x = cvt_pk(v[0], v[1]); w.y = cvt_pk(v[2], v[3]); w.z = cvt_pk(v[4], v[5]); w.w = cvt_pk(v[6], v[7]);
            *(u32x4*)(dst + (size_t)(5632 + j) * D_ + k0) = w;
        }
    }
    {
        const float* c = p.in[1]; const float* wada = p.in[2]; const float* bada = p.in[3];
        float* mod = (float*)(p.ws + WS_MOD);
        LAS float* red = (LAS float*)lds;
        LAS float* sc = (LAS float*)(lds + 8192);
        const int cl = tid & 31, ds = tid >> 5;
        if ((int)blockIdx.x < 288) {
            for (int i = tid; i < 4096; i += 512) sc[i] = siluf_(c[i]);
            __syncthreads();
        }
        for (int it = blockIdx.x; it < 288; it += gridDim.x) {
            const int col = it * 32 + cl;
            float a0 = 0.f, a1 = 0.f, a2 = 0.f, a3 = 0.f;
#pragma unroll 16
            for (int i = 0; i < 64; ++i) { const int d = ds * 64 + i; const float w = wada[(size_t)d * NMOD + col];
                a0 += sc[d] * w; a1 += sc[1024 + d] * w; a2 += sc[2048 + d] * w; a3 += sc[3072 + d] * w; }
            *(LAS f32x4*)(red + (ds * 32 + cl) * 4) = (f32x4){a0, a1, a2, a3};
            __syncthreads();
            if (tid < 128) { const int cl2 = tid & 31, b = tid >> 5; float s = bada[it * 32 + cl2];
#pragma unroll
                for (int q = 0; q < 16; ++q) s += red[(q * 32 + cl2) * 4 + b];
                mod[b * NMOD + it * 32 + cl2] = s; }
            __syncthreads();
        }
    }
}

template <bool MOD> __device__ __forceinline__ void norm_phase(const float* xin, const float* gain, const float* mod, bf16_t* H, float* fout) {
    const int lane = threadIdx.x & 63, w = threadIdx.x >> 6;
    for (int rb = blockIdx.x * 8 + w; rb < M_ / 8; rb += gridDim.x * 8) {
        const int r0 = rb * 8, b = r0 >> 12;
        f32x4 a[4], s[4];
#pragma unroll
        for (int i = 0; i < 4; ++i) { const int col = 4 * lane + 256 * i; const f32x4 g = *(const f32x4*)(gain + col);
            if (MOD) { const f32x4 scl = *(const f32x4*)(mod + (size_t)b * NMOD + 1024 + col); a[i] = g * (scl + 1.0f); s[i] = *(const f32x4*)(mod + (size_t)b * NMOD + col); }
            else { a[i] = g; s[i] = (f32x4){0.f, 0.f, 0.f, 0.f}; } }
#pragma unroll 2
        for (int r = 0; r < 8; ++r) {
            const size_t ro = (size_t)(r0 + r) * D_;
            f32x4 x[4]; float ss = 0.f;
#pragma unroll
            for (int i = 0; i < 4; ++i) { x[i] = *(const f32x4*)(xin + ro + 4 * lane + 256 * i); ss += (x[i][0] * x[i][0] + x[i][1] * x[i][1]) + (x[i][2] * x[i][2] + x[i][3] * x[i][3]); }
#pragma unroll
            for (int o = 32; o >= 1; o >>= 1) ss += __shfl_xor(ss, o);
            const float rinv = rsqrtf(ss * (1.0f / D_) + 1e-6f);
#pragma unroll
            for (int i = 0; i < 4; ++i) { const f32x4 h = x[i] * rinv * a[i] + s[i];
                if (MOD) { u32x2 o; o.x = cvt_pk(h[0], h[1]); o.y = cvt_pk(h[2], h[3]); *(u32x2*)(H + ro + 4 * lane + 256 * i) = o; }
                else *(f32x4*)(fout + ro + 4 * lane + 256 * i) = h; }
        }
    }
}

typedef const f32x4 (&AccRef)[2][2][4][2];
struct EpiSwiGLU {
    static constexpr bool PERM = true, AFTER_DRAIN = false;
    bf16_t* O;
    __device__ __forceinline__ void operator()(AccRef acc, const pg8::Unit& u, int wr, int wc, int fr, int fq) const {
        const int row0 = u.pm * 256 + wr * 64 + fr, col0 = u.pn * 128 + wc * 32 + 8 * fq;
#pragma unroll
        for (int ai = 0; ai < 2; ++ai)
#pragma unroll
            for (int m = 0; m < 4; ++m) {
                const f32x4 g0 = acc[ai][0][m][0], g1 = acc[ai][0][m][1], u0 = acc[ai][1][m][0], u1 = acc[ai][1][m][1];
                float v[8];
#pragma unroll
                for (int j = 0; j < 4; ++j) { v[j] = siluf_(g0[j]) * u0[j]; v[4 + j] = siluf_(g1[j]) * u1[j]; }
                u32x4 w; w.x = cvt_pk(v[0], v[1]); w.y = cvt_pk(v[2], v[3]); w.z = cvt_pk(v[4], v[5]); w.w = cvt_pk(v[6], v[7]);
                *(u32x4*)(O + (size_t)(row0 + ai * 128 + m * 16) * DFF + col0) = w;
            }
    }
};
struct EpiRes {
    static constexpr bool PERM = false, AFTER_DRAIN = false;
    const float* xin; float* xout; const float* gate; float coef;
    __device__ __forceinline__ void operator()(AccRef acc, const pg8::Unit& u, int wr, int wc, int fr, int fq) const {
        const int row0 = u.pm * 256 + wr * 64 + fr, col0 = u.pn * 256 + wc * 32 + 4 * fq, b = u.pm >> 4;
        f32x4 gv[2][2];
#pragma unroll
        for (int bj = 0; bj < 2; ++bj)
#pragma unroll
            for (int n = 0; n < 2; ++n) gv[bj][n] = *(const f32x4*)(gate + (size_t)b * NMOD + col0 + bj * 128 + n * 16) * coef;
#pragma unroll
        for (int ai = 0; ai < 2; ++ai)
#pragma unroll
            for (int m = 0; m < 4; ++m) { const size_t off = (size_t)(row0 + ai * 128 + m * 16) * D_ + col0;
#pragma unroll
                for (int bj = 0; bj < 2; ++bj)
#pragma unroll
                    for (int n = 0; n < 2; ++n) { const f32x4 xv = *(const f32x4*)(xin + off + bj * 128 + n * 16); *(f32x4*)(xout + off + bj * 128 + n * 16) = xv + gv[bj][n] * acc[ai][bj][m][n]; } }
    }
};
struct EpiMix {
    static constexpr bool PERM = true, AFTER_DRAIN = false;
    unsigned char* ws;
    __device__ __forceinline__ void operator()(AccRef acc, const pg8::Unit& u, int wr, int wc, int fr, int fq) const {
        const int pn = u.pn; size_t off; int ld, cb; bool sig = false;
        if (pn < 2) { off = WS_HQ; ld = 512; cb = pn * 256; }
        else if (pn < 4) { off = WS_HF; ld = 512; cb = (pn - 2) * 256; }
        else if (pn < 6) { off = WS_HI; ld = 512; cb = (pn - 4) * 256; }
        else if (pn < 8) { off = WS_HG; ld = 512; cb = (pn - 6) * 256; }
        else if (pn == 8) { off = WS_GQ; ld = 256; cb = 0; }
        else if (pn == 9) { off = WS_GK; ld = 256; cb = 0; }
        else if (pn < 12) { off = WS_GV; ld = 512; cb = (pn - 10) * 256; }
        else if (pn < 14) { off = WS_GG; ld = 512; cb = (pn - 12) * 256; }
        else if (pn < 18) { off = WS_RHG; ld = 1024; cb = (pn - 14) * 256; sig = true; }
        else if (pn < 22) { off = WS_RGLA; ld = 1024; cb = (pn - 18) * 256; sig = true; }
        else { off = WS_GKL; ld = 256; cb = 0; }
        bf16_t* base = (bf16_t*)(ws + off);
        const int row0 = u.pm * 256 + wr * 64 + fr, col0 = cb + wc * 32 + 8 * fq;
#pragma unroll
        for (int ai = 0; ai < 2; ++ai)
#pragma unroll
            for (int m = 0; m < 4; ++m) { bf16_t* rowp = base + (size_t)(row0 + ai * 128 + m * 16) * ld + col0;
#pragma unroll
                for (int bj = 0; bj < 2; ++bj) { f32x4 v0 = acc[ai][bj][m][0], v1 = acc[ai][bj][m][1];
                    if (sig) {
#pragma unroll
                        for (int j = 0; j < 4; ++j) { v0[j] = sigmoidf_(v0[j]); v1[j] = sigmoidf_(v1[j]); } }
                    u32x4 w; w.x = cvt_pk(v0[0], v0[1]); w.y = cvt_pk(v0[2], v0[3]); w.z = cvt_pk(v1[0], v1[1]); w.w = cvt_pk(v1[2], v1[3]);
                    *(u32x4*)(rowp + bj * 128) = w; } }
    }
};
template <bool SECOND> struct EpiUp {
    static constexpr bool PERM = true, AFTER_DRAIN = false;
    const bf16_t* R; float* T; bf16_t* O;
    __device__ __forceinline__ void operator()(AccRef acc, const pg8::Unit& u, int wr, int wc, int fr, int fq) const {
        const int row0 = u.pm * 256 + wr * 64 + fr, col0 = u.pn * 256 + wc * 32 + 8 * fq;
#pragma unroll
        for (int ai = 0; ai < 2; ++ai)
#pragma unroll
            for (int m = 0; m < 4; ++m) { const size_t off = (size_t)(row0 + ai * 128 + m * 16) * D_ + col0;
#pragma unroll
                for (int bj = 0; bj < 2; ++bj) { const u32x4 r = *(const u32x4*)(R + off + bj * 128);
                    const f32x4 s0 = (f32x4){bf_lo(r.x), bf_hi(r.x), bf_lo(r.y), bf_hi(r.y)}, s1 = (f32x4){bf_lo(r.z), bf_hi(r.z), bf_lo(r.w), bf_hi(r.w)};
                    f32x4 v0 = s0 * acc[ai][bj][m][0], v1 = s1 * acc[ai][bj][m][1];
                    if (!SECOND) { *(f32x4*)(T + off + bj * 128) = v0; *(f32x4*)(T + off + bj * 128 + 4) = v1; }
                    else { v0 += *(const f32x4*)(T + off + bj * 128); v1 += *(const f32x4*)(T + off + bj * 128 + 4);
                        u32x4 w; w.x = cvt_pk(v0[0], v0[1]); w.y = cvt_pk(v0[2], v0[3]); w.z = cvt_pk(v1[0], v1[1]); w.w = cvt_pk(v1[2], v1[3]);
                        *(u32x4*)(O + off + bj * 128) = w; } } }
    }
};

template <bool HG, bool WANTQ, int RPS>
__device__ __forceinline__ void load_decay(const Params& p, int row_first, int h, int col, float (&lg)[RPS], float (&kv)[RPS], float (&qv)[RPS]) {
    if constexpr (HG) {
        const bf16_t* F = (const bf16_t*)(p.ws + WS_HF) + (size_t)row_first * 512 + h * 128 + col;
        const bf16_t* Q = (const bf16_t*)(p.ws + WS_HQ) + (size_t)row_first * 512 + h * 128 + col;
        const float l0 = p.in[10][h * 128 + col], l1 = p.in[10][512 + h * 128 + col];
        const float lb = __builtin_amdgcn_rcpf(1.0f + __expf(l1 - l0));
        bf16_t fr[RPS], qr[RPS];
#pragma unroll
        for (int r = 0; r < RPS; ++r) { fr[r] = F[(size_t)r * 512]; if (WANTQ) qr[r] = Q[(size_t)r * 512]; }
#pragma unroll
        for (int r = 0; r < RPS; ++r) { const float sg = sigmoidf_(bf2f(fr[r])); const float fg = lb + (1.0f - lb) * sg; lg[r] = __logf(fg); kv[r] = 1.0f - fg; if (WANTQ) qv[r] = siluf_(bf2f(qr[r])); }
    } else {
        const bf16_t* Z = (const bf16_t*)(p.ws + WS_GKL) + (size_t)row_first * 256 + h * 64 + col;
        const bf16_t* Kp = (const bf16_t*)(p.ws + WS_GK) + (size_t)row_first * 256 + h * 64 + col;
        const bf16_t* Q = (const bf16_t*)(p.ws + WS_GQ) + (size_t)row_first * 256 + h * 64 + col;
        const float bg = p.in[9][h * 64 + col];
        bf16_t zr[RPS], kr[RPS], qr[RPS];
#pragma unroll
        for (int r = 0; r < RPS; ++r) { zr[r] = Z[(size_t)r * 256]; kr[r] = Kp[(size_t)r * 256]; if (WANTQ) qr[r] = Q[(size_t)r * 256]; }
#pragma unroll
        for (int r = 0; r < RPS; ++r) { const float z = bf2f(zr[r]) + bg; lg[r] = (fminf(z, 0.f) - __logf(1.0f + __expf(-fabsf(z)))) * (1.0f / 16.0f); kv[r] = bf2f(kr[r]); if (WANTQ) qv[r] = bf2f(qr[r]) * 0.125f; }
    }
}

template <bool HG> __device__ __forceinline__ void chunk_state_phase(const Params& p, LAS unsigned char* lds) {
    constexpr int DK = HG ? 128 : 64, NSEG = 512 / DK, RPS = 64 / NSEG;
    const int tid = threadIdx.x, lane = tid & 63, w = tid >> 6, col = tid & (DK - 1), seg = tid / DK, vcol = tid & 127, vseg = tid >> 7, fr = lane & 15, fq = lane >> 4;
    LAS float* SEG = (LAS float*)(lds + L_SEG);
    const bf16_t* V = (const bf16_t*)(p.ws + (HG ? WS_HI : WS_GV));
    bf16_t* UT = (bf16_t*)(p.ws + (HG ? WS_UHG : WS_UGLA));
    float* DEC = (float*)(p.ws + (HG ? WS_DECHG : WS_DECGLA));
    for (int it = blockIdx.x; it < 1024; it += gridDim.x) {
        const int bh = it >> 6, chunk = it & 63, b = bh >> 2, h = bh & 3, row0 = b * SEQ + chunk * 64;
        float lg[RPS], kv[RPS], qv[RPS];
        load_decay<HG, false, RPS>(p, row0 + seg * RPS, h, col, lg, kv, qv);
        bf16_t vr[16];
        { const bf16_t* vp = V + (size_t)(row0 + vseg * 16) * 512 + h * 128 + vcol;
#pragma unroll
            for (int r = 0; r < 16; ++r) vr[r] = vp[(size_t)r * 512]; }
#pragma unroll
        for (int r = 1; r < RPS; ++r) lg[r] += lg[r - 1];
        SEG[seg * DK + col] = lg[RPS - 1];
        __syncthreads();
        float off = 0.f, tot = 0.f;
#pragma unroll
        for (int s = 0; s < NSEG; ++s) { const float v = SEG[s * DK + col]; if (s < seg) off += v; tot += v; }
        unsigned pk[RPS / 2];
#pragma unroll
        for (int r = 0; r < RPS; r += 2) pk[r / 2] = cvt_pk(kv[r] * __expf(tot - (lg[r] + off)), kv[r + 1] * __expf(tot - (lg[r + 1] + off)));
        { LAS u32x4* dp = (LAS u32x4*)(lds + L_QD + (col * 72 + seg * RPS) * 2);
            dp[0] = (u32x4){pk[0], pk[1], pk[2], pk[3]};
            if constexpr (RPS == 16) dp[1] = (u32x4){pk[4], pk[5], pk[6], pk[7]}; }
        if (seg == 0) DEC[(size_t)it * DK + col] = __expf(tot);
        { LAS u32x4* dp = (LAS u32x4*)(lds + L_VT + (vcol * 72 + vseg * 16) * 2);
            dp[0] = (u32x4){(unsigned)vr[0] | ((unsigned)vr[1] << 16), (unsigned)vr[2] | ((unsigned)vr[3] << 16), (unsigned)vr[4] | ((unsigned)vr[5] << 16), (unsigned)vr[6] | ((unsigned)vr[7] << 16)};
            dp[1] = (u32x4){(unsigned)vr[8] | ((unsigned)vr[9] << 16), (unsigned)vr[10] | ((unsigned)vr[11] << 16), (unsigned)vr[12] | ((unsigned)vr[13] << 16), (unsigned)vr[14] | ((unsigned)vr[15] << 16)}; }
        __syncthreads();
        bf16x8 bfr[2];
#pragma unroll
        for (int ks = 0; ks < 2; ++ks) bfr[ks] = *(const LAS bf16x8*)(lds + L_VT + ((16 * w + fr) * 72 + 32 * ks + 8 * fq) * 2);
#pragma unroll
        for (int kt = 0; kt < DK / 16; ++kt) {
            f32x4 acc = (f32x4){0.f, 0.f, 0.f, 0.f};
#pragma unroll
            for (int ks = 0; ks < 2; ++ks) { const bf16x8 af = *(const LAS bf16x8*)(lds + L_QD + ((16 * kt + fr) * 72 + 32 * ks + 8 * fq) * 2);
                acc = __builtin_amdgcn_mfma_f32_16x16x32_bf16(af, bfr[ks], acc, 0, 0, 0); }
            u32x2 o; o.x = cvt_pk(acc[0], acc[1]); o.y = cvt_pk(acc[2], acc[3]);
            *(u32x2*)(UT + ((size_t)it * 128 + 16 * w + fr) * DK + 16 * kt + 4 * fq) = o;
        }
    }
}

__device__ __forceinline__ void scan_phase(const Params& p) {
    for (int e = blockIdx.x * 512 + threadIdx.x; e < 98304; e += gridDim.x * 512) {
        bf16_t* U; const float* dec; size_t us, dstr;
        if (e < 65536) { const int bh = e >> 12, rem = e & 4095, v = rem >> 5, kq = rem & 31;
            U = (bf16_t*)(p.ws + WS_UHG) + ((size_t)(bh * 64) * 128 + v) * 128 + 4 * kq; dec = (const float*)(p.ws + WS_DECHG) + (size_t)bh * 64 * 128 + 4 * kq; us = 128 * 128; dstr = 128; }
        else { const int e2 = e - 65536, bh = e2 >> 11, rem = e2 & 2047, v = rem >> 4, kq = rem & 15;
            U = (bf16_t*)(p.ws + WS_UGLA) + ((size_t)(bh * 64) * 128 + v) * 64 + 4 * kq; dec = (const float*)(p.ws + WS_DECGLA) + (size_t)bh * 64 * 64 + 4 * kq; us = 128 * 64; dstr = 64; }
        f32x4 S = (f32x4){0.f, 0.f, 0.f, 0.f};
        for (int c0 = 0; c0 < 64; c0 += 8) {
            u32x2 uu[8]; f32x4 dd[8];
#pragma unroll
            for (int j = 0; j < 8; ++j) { uu[j] = *(const u32x2*)(U + (size_t)(c0 + j) * us); dd[j] = *(const f32x4*)(dec + (size_t)(c0 + j) * dstr); }
#pragma unroll
            for (int j = 0; j < 8; ++j) { u32x2 o; o.x = cvt_pk(S[0], S[1]); o.y = cvt_pk(S[2], S[3]); *(u32x2*)(U + (size_t)(c0 + j) * us) = o;
                const f32x4 uv = (f32x4){bf_lo(uu[j].x), bf_hi(uu[j].x), bf_lo(uu[j].y), bf_hi(uu[j].y)}; S = dd[j] * S + uv; }
        }
    }
}

template <bool HG> __device__ __forceinline__ void chunk_out_phase(const Params& p, LAS unsigned char* lds) {
    constexpr int DK = HG ? 128 : 64, NSEG = 512 / DK, RPS = 64 / NSEG, LDQ = DK + 8;
    const int tid = threadIdx.x, lane = tid & 63, w = tid >> 6, col = tid & (DK - 1), seg = tid / DK, vcol = tid & 127, vseg = tid >> 7, fr = lane & 15, fq = lane >> 4;
    LAS float* SEG = (LAS float*)(lds + L_SEG);
    LAS float* SS = (LAS float*)(lds + L_SS);
    const bf16_t* V = (const bf16_t*)(p.ws + (HG ? WS_HI : WS_GV));
    const bf16_t* ST = (const bf16_t*)(p.ws + (HG ? WS_UHG : WS_UGLA));
    bf16_t* G = (bf16_t*)(p.ws + (HG ? WS_HG : WS_GG));
    const f32x4 gn = *(const f32x4*)(p.in[HG ? 11 : 12] + 16 * w + 4 * fq);
    for (int it = blockIdx.x; it < 1024; it += gridDim.x) {
        const int bh = it >> 6, chunk = it & 63, b = bh >> 2, h = bh & 3, row0 = b * SEQ + chunk * 64;
        bf16x8 stf[DK / 32];
#pragma unroll
        for (int ks = 0; ks < DK / 32; ++ks) stf[ks] = *(const bf16x8*)(ST + ((size_t)it * 128 + 16 * w + fr) * DK + 32 * ks + 8 * fq);
        float lg[RPS], kv[RPS], qv[RPS];
        load_decay<HG, true, RPS>(p, row0 + seg * RPS, h, col, lg, kv, qv);
        bf16_t vr[16];
        { const bf16_t* vp = V + (size_t)(row0 + vseg * 16) * 512 + h * 128 + vcol;
#pragma unroll
            for (int r = 0; r < 16; ++r) vr[r] = vp[(size_t)r * 512]; }
#pragma unroll
        for (int r = 1; r < RPS; ++r) lg[r] += lg[r - 1];
        SEG[seg * DK + col] = lg[RPS - 1];
        __syncthreads();
        float off = 0.f, bref = 0.f;
#pragma unroll
        for (int s = 0; s < NSEG; ++s) { const float v = SEG[s * DK + col]; if (s < seg) off += v; if (s < NSEG / 2) bref += v; }
#pragma unroll
        for (int r = 0; r < RPS; r += 2) {
            const float b0 = lg[r] + off, b1 = lg[r + 1] + off; const int t = seg * RPS + r;
            const unsigned qd = cvt_pk(qv[r] * __expf(b0), qv[r + 1] * __expf(b1));
            const unsigned qm = cvt_pk(qv[r] * __expf(fminf(b0 - bref, 40.f)), qv[r + 1] * __expf(fminf(b1 - bref, 40.f)));
            const unsigned km = cvt_pk(kv[r] * __expf(fminf(bref - b0, 40.f)), kv[r + 1] * __expf(fminf(bref - b1, 40.f)));
            *(LAS bf16_t*)(lds + L_QD + (t * LDQ + col) * 2) = (bf16_t)(qd & 0xffffu); *(LAS bf16_t*)(lds + L_QD + ((t + 1) * LDQ + col) * 2) = (bf16_t)(qd >> 16);
            *(LAS bf16_t*)(lds + L_QM + (t * LDQ + col) * 2) = (bf16_t)(qm & 0xffffu); *(LAS bf16_t*)(lds + L_QM + ((t + 1) * LDQ + col) * 2) = (bf16_t)(qm >> 16);
            *(LAS bf16_t*)(lds + L_KM + (t * LDQ + col) * 2) = (bf16_t)(km & 0xffffu); *(LAS bf16_t*)(lds + L_KM + ((t + 1) * LDQ + col) * 2) = (bf16_t)(km >> 16);
        }
        { LAS u32x4* dp = (LAS u32x4*)(lds + L_VT + (vcol * 72 + vseg * 16) * 2);
            dp[0] = (u32x4){(unsigned)vr[0] | ((unsigned)vr[1] << 16), (unsigned)vr[2] | ((unsigned)vr[3] << 16), (unsigned)vr[4] | ((unsigned)vr[5] << 16), (unsigned)vr[6] | ((unsigned)vr[7] << 16)};
            dp[1] = (u32x4){(unsigned)vr[8] | ((unsigned)vr[9] << 16), (unsigned)vr[10] | ((unsigned)vr[11] << 16), (unsigned)vr[12] | ((unsigned)vr[13] << 16), (unsigned)vr[14] | ((unsigned)vr[15] << 16)}; }
        u32x2 gr[4];
#pragma unroll
        for (int tb = 0; tb < 4; ++tb) gr[tb] = *(const u32x2*)(G + (size_t)(row0 + 16 * tb + fr) * 512 + h * 128 + 16 * w + 4 * fq);
        __syncthreads();
#pragma unroll
        for (int j = 0; j < 2; ++j) {
            const int tb = w >> 1, sb = (w & 1) * 2 + j;
            f32x4 acc = (f32x4){0.f, 0.f, 0.f, 0.f};
            if (sb <= tb) {
#pragma unroll
                for (int ks = 0; ks < DK / 32; ++ks) {
                    const bf16x8 af = *(const LAS bf16x8*)(lds + L_KM + ((16 * sb + fr) * LDQ + 32 * ks + 8 * fq) * 2);
                    const bf16x8 bq = *(const LAS bf16x8*)(lds + L_QM + ((16 * tb + fr) * LDQ + 32 * ks + 8 * fq) * 2);
                    acc = __builtin_amdgcn_mfma_f32_16x16x32_bf16(af, bq, acc, 0, 0, 0);
                }
                const int t = 16 * tb + fr, s0 = 16 * sb + 4 * fq;
#pragma unroll
                for (int i = 0; i < 4; ++i) if (s0 + i > t) acc[i] = 0.f;
            }
            u32x2 o; o.x = cvt_pk(acc[0], acc[1]); o.y = cvt_pk(acc[2], acc[3]);
            *(LAS u32x2*)(lds + L_P + ((16 * tb + fr) * 72 + 16 * sb + 4 * fq) * 2) = o;
        }
        __syncthreads();
        bf16x8 vtf[2];
#pragma unroll
        for (int ks = 0; ks < 2; ++ks) vtf[ks] = *(const LAS bf16x8*)(lds + L_VT + ((16 * w + fr) * 72 + 32 * ks + 8 * fq) * 2);
        f32x4 acc[4];
#pragma unroll
        for (int tb = 0; tb < 4; ++tb) {
            acc[tb] = (f32x4){0.f, 0.f, 0.f, 0.f};
#pragma unroll
            for (int ks = 0; ks < DK / 32; ++ks) { const bf16x8 bq = *(const LAS bf16x8*)(lds + L_QD + ((16 * tb + fr) * LDQ + 32 * ks + 8 * fq) * 2);
                acc[tb] = __builtin_amdgcn_mfma_f32_16x16x32_bf16(stf[ks], bq, acc[tb], 0, 0, 0); }
#pragma unroll
            for (int ks = 0; ks < 2; ++ks) { const bf16x8 pf = *(const LAS bf16x8*)(lds + L_P + ((16 * tb + fr) * 72 + 32 * ks + 8 * fq) * 2);
                acc[tb] = __builtin_amdgcn_mfma_f32_16x16x32_bf16(vtf[ks], pf, acc[tb], 0, 0, 0); }
            float ss = (acc[tb][0] * acc[tb][0] + acc[tb][1] * acc[tb][1]) + (acc[tb][2] * acc[tb][2] + acc[tb][3] * acc[tb][3]);
            ss += __shfl_xor(ss, 16); ss += __shfl_xor(ss, 32);
            if (lane < 16) SS[(16 * tb + lane) * 8 + w] = ss;
        }
        __syncthreads();
#pragma unroll
        for (int tb = 0; tb < 4; ++tb) {
            const int t = 16 * tb + fr;
            const f32x4 s0 = *(const LAS f32x4*)(SS + t * 8), s1 = *(const LAS f32x4*)(SS + t * 8 + 4);
            const float tot = ((s0[0] + s0[1]) + (s0[2] + s0[3])) + ((s1[0] + s1[1]) + (s1[2] + s1[3]));
            const float rinv = rsqrtf(tot * (1.0f / 128.0f) + 1e-6f);
            const float g0 = bf_lo(gr[tb].x), g1 = bf_hi(gr[tb].x), g2 = bf_lo(gr[tb].y), g3 = bf_hi(gr[tb].y);
            u32x2 o; o.x = cvt_pk(acc[tb][0] * rinv * gn[0] * siluf_(g0), acc[tb][1] * rinv * gn[1] * siluf_(g1));
            o.y = cvt_pk(acc[tb][2] * rinv * gn[2] * siluf_(g2), acc[tb][3] * rinv * gn[3] * siluf_(g3));
            *(u32x2*)(G + (size_t)(row0 + t) * 512 + h * 128 + 16 * w + 4 * fq) = o;
        }
    }
}

#define XB_TMO      128
#define XB_XCNT(j)  (256  + 64 * (j))
#define XB_XSUB(j)  (1280 + 64 * (j))
#define XB_XGEN(j)  (2304 + 64 * (j))
#define XB_TOP      3328
#define XB_TOPGEN   3392
#define XCD_BAR_WORDS 3456
#define XB_SPIN_CAP (1u << 18)

__device__ __forceinline__ unsigned xb_ld(unsigned* p)              { return __hip_atomic_load(p, __ATOMIC_RELAXED, __HIP_MEMORY_SCOPE_AGENT); }
__device__ __forceinline__ unsigned xb_add(unsigned* p, unsigned v) { return __hip_atomic_fetch_add(p, v, __ATOMIC_RELAXED, __HIP_MEMORY_SCOPE_AGENT); }
__device__ __forceinline__ unsigned xb_xcc_id() { return (unsigned)__builtin_amdgcn_s_getreg((3 << 11) | 20) & 0xFu; }
#define XB_SPIN(cond, bar) do { unsigned _sp = 0; while (cond) { __builtin_amdgcn_s_sleep(1); \
    if ((++_sp & 255u) == 0u) { if (xb_ld(&(bar)[XB_TMO])) break; if (_sp > XB_SPIN_CAP) { atomicAdd(&(bar)[XB_TMO], 1u); break; } } } } while (0)

struct XcdBarrier {
    unsigned* bar; unsigned x;
    volatile LAS unsigned* st;
};

__device__ __forceinline__ XcdBarrier xcd_barrier_post(unsigned* bar, volatile LAS unsigned* st) {
    XcdBarrier b; b.bar = bar; b.x = xb_xcc_id(); b.st = st;
    if (threadIdx.x == 0) (void)xb_add(&bar[XB_XCNT(b.x)], 1u);
    return b;
}
__device__ __forceinline__ void xcd_barrier_complete(unsigned* bar, unsigned x, unsigned& nloc, unsigned& nx) {
    const unsigned G = gridDim.x * gridDim.y * gridDim.z;
    unsigned sum, cnt, mine, sp = 0u;
    for (;;) {
        sum = 0u; cnt = 0u; mine = 0u;
#pragma unroll
        for (unsigned j = 0; j < 16; ++j) { const unsigned c = xb_ld(&bar[XB_XCNT(j)]); sum += c; cnt += (c > 0u) ? 1u : 0u; mine = (j == x) ? c : mine; }
        if (sum == G) break;
        __builtin_amdgcn_s_sleep(1);
        if ((++sp & 255u) == 0u) { if (xb_ld(&bar[XB_TMO])) break; if (sp > XB_SPIN_CAP) { atomicAdd(&bar[XB_TMO], 1u); break; } }
    }
    nloc = mine > 0u ? mine : 1u; nx = cnt > 0u ? cnt : 1u;
}

__device__ __forceinline__ void xcd_barrier(const XcdBarrier& b) {
    asm volatile("s_waitcnt vmcnt(0)" ::: "memory");
    __syncthreads();
    if (threadIdx.x == 0) {
        unsigned* bar = b.bar;
        __builtin_amdgcn_s_waitcnt(0);
        unsigned nloc = b.st[0], nx = b.st[1];
        if (nloc == 0u) { xcd_barrier_complete(bar, b.x, nloc, nx); b.st[0] = nloc; b.st[1] = nx; }
        const unsigned old = xb_add(&bar[XB_XSUB(b.x)], 1u);
        const unsigned gen = old / nloc;
        if (old + 1u == (gen + 1u) * nloc) {
            __builtin_amdgcn_fence(__ATOMIC_RELEASE, "agent");
            asm volatile("s_waitcnt vmcnt(0)" ::: "memory");
            const unsigned og = xb_add(&bar[XB_TOP], 1u);
            const unsigned tg = og / nx;
            if (og + 1u == (tg + 1u) * nx) xb_add(&bar[XB_TOPGEN], 1u);
            else XB_SPIN(xb_ld(&bar[XB_TOPGEN]) == tg, bar);
            __builtin_amdgcn_fence(__ATOMIC_ACQUIRE, "agent");
            xb_add(&bar[XB_XGEN(b.x)], 1u);
            asm volatile("s_waitcnt vmcnt(0)" ::: "memory");
        } else {
            XB_SPIN(xb_ld(&bar[XB_XGEN(b.x)]) == gen, bar);
            __builtin_amdgcn_fence(__ATOMIC_ACQUIRE, "agent");
            asm volatile("s_waitcnt vmcnt(0)" ::: "memory");
        }
    }
    __syncthreads();
}

template <class Epi> __device__ __forceinline__ void run_gemm(LAS unsigned char* lds, const bf16_t* A, const bf16_t* Bt, int N, int K, const Epi& E) {
    pg8::Gemm g{A, Bt, M_, N, K}; pg8::StaticOrder S; S.init(M_, N, (int)gridDim.x, (int)blockIdx.x);
    pg8::gemm_phase<Epi, pg8::StaticOrder>(lds, g, S, E, nullptr);
}

__global__ void __launch_bounds__(512, 2) fwd_kernel(Params p) {
    extern __shared__ __attribute__((aligned(16))) unsigned char smem[];
    LAS unsigned char* lds = (LAS unsigned char*)smem;
    cg::grid_group grid = cg::this_grid();
    if (p.ws == nullptr) grid.sync();
    { volatile LAS unsigned* st = (volatile LAS unsigned*)(lds + 131072); if (threadIdx.x < 4) st[threadIdx.x] = 0u; }
    __syncthreads();
    const XcdBarrier bar = xcd_barrier_post((unsigned*)(p.ws + WS_BAR), (volatile LAS unsigned*)(lds + 131072));
#define GRID_SYNC() xcd_barrier(bar)
    unsigned char* ws = p.ws;
    const float* mod = (const float*)(ws + WS_MOD);
    bf16_t* H = (bf16_t*)(ws + WS_H);
    bf16_t* ACT = (bf16_t*)(ws + WS_ACT);
    float* X = p.out;

    p0_phase(p, lds);
    GRID_SYNC();
    norm_phase<true>(p.in[0], p.in[4], mod, H, nullptr);
    GRID_SYNC();
    run_gemm(lds, H, (const bf16_t*)(ws + WS_WFIN), 2 * DFF, D_, EpiSwiGLU{ACT});
    GRID_SYNC();
    run_gemm(lds, ACT, (const bf16_t*)(ws + WS_WFDOWN), D_, DFF, EpiRes{p.in[0], X, mod + 2 * D_, 0.5f});
    GRID_SYNC();
    norm_phase<true>(X, p.in[4] + D_, mod + 3 * D_, H, nullptr);
    GRID_SYNC();
    run_gemm(lds, H, (const bf16_t*)(ws + WS_WMIX), NMIX, D_, EpiMix{ws});
    GRID_SYNC();
    chunk_state_phase<true>(p, lds); chunk_state_phase<false>(p, lds);
    GRID_SYNC();
    scan_phase(p);
    GRID_SYNC();
    chunk_out_phase<true>(p, lds); chunk_out_phase<false>(p, lds);
    GRID_SYNC();
    run_gemm(lds, (const bf16_t*)(ws + WS_HG), (const bf16_t*)(ws + WS_WUPHG), D_, 512, EpiUp<false>{(const bf16_t*)(ws + WS_RHG), (float*)(ws + WS_T), nullptr});
    run_gemm(lds, (const bf16_t*)(ws + WS_GG), (const bf16_t*)(ws + WS_WUPGLA), D_, 512, EpiUp<true>{(const bf16_t*)(ws + WS_RGLA), (float*)(ws + WS_T), H});
    GRID_SYNC();
    run_gemm(lds, H, (const bf16_t*)(ws + WS_WOUT), D_, D_, EpiRes{X, X, mod + 5 * D_, 1.0f});
    GRID_SYNC();
    norm_phase<true>(X, p.in[4] + 2 * D_, mod + 6 * D_, H, nullptr);
    cvt_ffn(p.in[16], p.in[17], ws);
    GRID_SYNC();
    run_gemm(lds, H, (const bf16_t*)(ws + WS_WFIN), 2 * DFF, D_, EpiSwiGLU{ACT});
    GRID_SYNC();
    run_gemm(lds, ACT, (const bf16_t*)(ws + WS_WFDOWN), D_, DFF, EpiRes{X, X, mod + 8 * D_, 0.5f});
    GRID_SYNC();
    norm_phase<false>(X, p.in[18], nullptr, nullptr, X);
}

extern "C" void kernel_launch(void* const* d_in, const int* in_sizes, int n_in, void* d_out, int out_size, void* d_ws, size_t ws_size, hipStream_t stream) {
    static int grid = 0;
    if (grid == 0) {
        if (n_in != 19 || out_size != M_ * D_ || ws_size < WS_BAR + XCD_BAR_WORDS * 4) { fprintf(stderr, "kernel_launch: unexpected shapes (n_in %d out %d ws %zu)\n", n_in, out_size, ws_size); grid = -1; return; }
        int dev = 0, cus = 0, per_cu = 0;
        (void)hipGetDevice(&dev); (void)hipDeviceGetAttribute(&cus, hipDeviceAttributeMultiprocessorCount, dev);
        if (hipFuncSetAttribute((const void*)fwd_kernel, hipFuncAttributeMaxDynamicSharedMemorySize, LDS_BYTES) != hipSuccess) { fprintf(stderr, "kernel_launch: hipFuncSetAttribute failed\n"); grid = -1; return; }
        if (hipOccupancyMaxActiveBlocksPerMultiprocessor(&per_cu, (const void*)fwd_kernel, 512, LDS_BYTES) != hipSuccess || per_cu < 1) per_cu = 1;
        (void)hipGetLastError();
        grid = cus * per_cu;
    }
    if (grid < 0) return;
    (void)hipMemsetAsync((unsigned char*)d_ws + WS_BAR, 0, XCD_BAR_WORDS * 4, stream);
    Params p{};
    for (int i = 0; i < 19; ++i) p.in[i] = (const float*)d_in[i];
    p.out = (float*)d_out; p.ws = (unsigned char*)d_ws;
    void* args[] = {&p};
    hipError_t e = hipLaunchCooperativeKernel((const void*)fwd_kernel, dim3(grid), dim3(512), args, LDS_BYTES, stream);
    if (e != hipSuccess) fprintf(stderr, "cooperative launch failed: %s (grid %d)\n", hipGetErrorString(e), grid);
}
```
